# Optimizing an MI355X kernel written in HIP

```python
import jax, jax.numpy as jnp
from jax import lax
import numpy as np

D_MODEL = 2048
BATCH = 2
SEQ = 16384
DEPTH = 4
DEC_BATCH = 32
DEC_SEQ = 16
PAST_LEN = 1024

CHUNK = 64
LEFT_CHUNKS = 8
BAND_PAST = LEFT_CHUNKS * CHUNK
BAND = BAND_PAST + CHUNK
REL_CLIP = 128
TOK_W = 1024
A_HEADS = 8
A_DIM = 128
B_HEADS = 4
B_DIM = 256
N_MEM_HEADS = 4
MEM_DIM = 128
MEM_W = N_MEM_HEADS * MEM_DIM
IN_W = 3 * TOK_W + MEM_W
N_MEM = 256
D_FF = 3072
SB_BLOCK = 128
N_A_LAYERS = (DEPTH + 1) // 2
N_B_LAYERS = DEPTH // 2
EPS = 1e-6
NEG_INF = -1e30
SB_NEG = -1e4

kernel_name = 'hybrid_streaming_band_stickbreak_encoder'


def _normalize(x):
    x32 = x.astype(jnp.float32)
    r = lax.rsqrt(jnp.mean(x32 * x32, axis=-1, keepdims=True) + EPS)
    return (x32 * r).astype(x.dtype)


def _rms(x, g):
    return (_normalize(x).astype(jnp.float32) * g.astype(jnp.float32)).astype(x.dtype)


def _ffn(x, g, w_in, w_out):
    n = _normalize(x)
    w = g[:, None] * w_in
    a = n @ w[:, :D_FF]
    b = n @ w[:, D_FF:]
    return (jax.nn.silu(a) * b) @ (0.5 * w_out)


def _project(x, g, w_in, heads, dim):
    B, T, _ = x.shape
    n = _normalize(x)
    w = g[:, None] * w_in
    q = (n @ w[:, :TOK_W]).reshape(B, T, heads, dim)
    k = (n @ w[:, TOK_W:2 * TOK_W]).reshape(B, T, heads, dim)
    v = (n @ w[:, 2 * TOK_W:3 * TOK_W]).reshape(B, T, heads, dim)
    qm = (n @ w[:, 3 * TOK_W:]).reshape(B, T, N_MEM_HEADS, MEM_DIM)
    return q, k, v, qm


def _merge(tok, mo, w_out):
    B, T = tok.shape[:2]
    return jnp.concatenate([tok.reshape(B, T, TOK_W), mo.reshape(B, T, MEM_W)], axis=-1) @ w_out


def _mem_kv(mem, g, w_kv, k_gain):
    B, M, _ = mem.shape
    kv = _normalize(mem) @ (g[:, None] * w_kv)
    mk = _rms(kv[..., :MEM_W].reshape(B, M, N_MEM_HEADS, MEM_DIM), k_gain)
    mv = kv[..., MEM_W:].reshape(B, M, N_MEM_HEADS, MEM_DIM)
    return mk, mv


def _mem_attn(qm, q_gain, mk, mv):
    q = _rms(qm, q_gain) * (MEM_DIM ** -0.5)
    s = jnp.einsum('bqhd,bmhd->bhqm', q, mk).astype(jnp.float32)
    p = jax.nn.softmax(s, axis=-1).astype(mv.dtype)
    return jnp.einsum('bhqm,bmhd->bqhd', p, mv)


def _band_bias(rel_bias, q_pos, k_pos):
    rel = jnp.clip(q_pos[:, None] - k_pos[None, :], -REL_CLIP, REL_CLIP) + REL_CLIP
    qc = q_pos // CHUNK
    kc = k_pos // CHUNK
    valid = (k_pos[None, :] >= 0) & (kc[None, :] <= qc[:, None]) & (kc[None, :] >= qc[:, None] - LEFT_CHUNKS)
    return jnp.where(valid[None], rel_bias[:, rel].astype(jnp.float32), NEG_INF)


def _band_core(q, k, v, bias):
    s = jnp.einsum('bqhd,bkhd->bhqk', q, k).astype(jnp.float32) + bias[None]
    p = jax.nn.softmax(s, axis=-1).astype(v.dtype)
    return jnp.einsum('bhqk,bkhd->bqhd', p, v)


def _band_prompt(q, k, v, rel_bias):
    B, T, H, Dh = q.shape
    pad = ((0, 0), (BAND_PAST, 0), (0, 0), (0, 0))
    k_pad = jnp.pad(k, pad)
    v_pad = jnp.pad(v, pad)
    bias0 = _band_bias(rel_bias, BAND_PAST + jnp.arange(CHUNK), jnp.arange(BAND))

    def one_chunk(c):
        start = c * CHUNK
        q_c = lax.dynamic_slice_in_dim(q, start, CHUNK, axis=1)
        k_c = lax.dynamic_slice_in_dim(k_pad, start, BAND, axis=1)
        v_c = lax.dynamic_slice_in_dim(v_pad, start, BAND, axis=1)
        k_pos = start - BAND_PAST + jnp.arange(BAND)
        bias = bias0 + jnp.where(k_pos >= 0, 0.0, NEG_INF)[None, None, :]
        return _band_core(q_c, k_c, v_c, bias)

    out = lax.map(one_chunk, jnp.arange(T // CHUNK))
    return jnp.moveaxis(out, 0, 1).reshape(B, T, H, Dh)


def _sb_attend(q, kp, vp, kd, vd, diag_mask):
    f32 = jnp.float32
    zd = jnp.where(diag_mask[None, None], jnp.einsum('bqhd,bkhd->bhqk', q, kd).astype(f32), SB_NEG)
    td = zd.shape[-1]
    u_d = (jnp.arange(td)[:, None] >= jnp.arange(td)[None, :]).astype(f32)
    loc_d = jnp.log1p(jnp.exp(zd)) @ u_d
    out = jnp.einsum('bhqk,bkhd->bqhd', jnp.exp(zd - loc_d).astype(vd.dtype), vd)
    n = kp.shape[1]
    if n:
        zo = jnp.einsum('bqhd,bnkhd->bhqnk', q, kp).astype(f32)
        u = (jnp.arange(SB_BLOCK)[:, None] >= jnp.arange(SB_BLOCK)[None, :]).astype(f32)
        loc_o = jnp.einsum('bhqnk,kj->bhqnj', jnp.log1p(jnp.exp(zo)), u)
        later = (jnp.arange(n)[:, None] > jnp.arange(n)[None, :]).astype(f32)
        aft = jnp.einsum('bhqm,mn->bhqn', loc_o[..., 0], later) + loc_d[..., 0:1]
        w = jnp.exp(zo - loc_o - aft[..., None]).astype(vp.dtype)
        out = out + jnp.einsum('bhqnk,bnkhd->bqhd', w, vp)
    return out


def _sb_prompt(q, k, v):
    B, T, H, Dh = q.shape
    mask = jnp.arange(SB_BLOCK)[None, :] < jnp.arange(SB_BLOCK)[:, None]
    outs = []
    for i in range(T // SB_BLOCK):
        lo, hi = i * SB_BLOCK, (i + 1) * SB_BLOCK
        kp = k[:, :lo].reshape(B, i, SB_BLOCK, H, Dh)
        vp = v[:, :lo].reshape(B, i, SB_BLOCK, H, Dh)
        outs.append(_sb_attend(q[:, lo:hi], kp, vp, k[:, lo:hi], v[:, lo:hi], mask))
    return jnp.concatenate(outs, axis=1)


def setup_inputs(seed: int = 0) -> dict:
    key = jax.random.key(seed)
    ks = jax.random.split(key, 32)
    f32 = jnp.float32
    a_cache = min(BAND_PAST, PAST_LEN)
    nrm = lambda k, shape, scale=1.0: jax.random.normal(k, shape, f32) * scale
    gain = lambda k, shape: 1.0 + 0.02 * jax.random.normal(k, shape, f32)
    return {
        'x_prompt': nrm(ks[0], (BATCH, SEQ, D_MODEL)),
        'x_sample': nrm(ks[1], (DEC_BATCH, DEC_SEQ, D_MODEL)),
        'mem_prompt': nrm(ks[2], (BATCH, N_MEM, D_MODEL)),
        'cache_a_k': nrm(ks[3], (N_A_LAYERS, DEC_BATCH, a_cache, A_HEADS, A_DIM)),
        'cache_a_v': nrm(ks[4], (N_A_LAYERS, DEC_BATCH, a_cache, A_HEADS, A_DIM)),
        'cache_b_k': nrm(ks[5], (N_B_LAYERS, DEC_BATCH, PAST_LEN, B_HEADS, B_DIM)),
        'cache_b_v': nrm(ks[6], (N_B_LAYERS, DEC_BATCH, PAST_LEN, B_HEADS, B_DIM)),
        'cache_mem_k': nrm(ks[7], (DEPTH, DEC_BATCH, N_MEM, N_MEM_HEADS, MEM_DIM)),
        'cache_mem_v': nrm(ks[8], (DEPTH, DEC_BATCH, N_MEM, N_MEM_HEADS, MEM_DIM)),
        'ffn1_norm': gain(ks[9], (DEPTH, D_MODEL)),
        'ffn1_w_in': nrm(ks[10], (DEPTH, D_MODEL, 2 * D_FF), D_MODEL ** -0.5),
        'ffn1_w_out': nrm(ks[11], (DEPTH, D_FF, D_MODEL), D_FF ** -0.5),
        'attn_norm': gain(ks[12], (DEPTH, D_MODEL)),
        'w_in': nrm(ks[13], (DEPTH, D_MODEL, IN_W), D_MODEL ** -0.5),
        'w_out': nrm(ks[14], (DEPTH, TOK_W + MEM_W, D_MODEL), (TOK_W + MEM_W) ** -0.5),
        'a_q_gain': gain(ks[15], (N_A_LAYERS, A_DIM)),
        'a_k_gain': gain(ks[16], (N_A_LAYERS, A_DIM)),
        'a_rel_bias': nrm(ks[17], (N_A_LAYERS, A_HEADS, 2 * REL_CLIP + 1), 0.1),
        'mem_norm': gain(ks[18], (DEPTH, D_MODEL)),
        'w_mem_kv': nrm(ks[19], (DEPTH, D_MODEL, 2 * MEM_W), D_MODEL ** -0.5),
        'mem_q_gain': gain(ks[20], (DEPTH, MEM_DIM)),
        'mem_k_gain': gain(ks[21], (DEPTH, MEM_DIM)),
        'ffn2_norm': gain(ks[22], (DEPTH, D_MODEL)),
        'ffn2_w_in': nrm(ks[23], (DEPTH, D_MODEL, 2 * D_FF), D_MODEL ** -0.5),
        'ffn2_w_out': nrm(ks[24], (DEPTH, D_FF, D_MODEL), D_FF ** -0.5),
    }


def reference(x_prompt, x_sample, mem_prompt, cache_a_k, cache_a_v, cache_b_k, cache_b_v,
              cache_mem_k, cache_mem_v, ffn1_norm, ffn1_w_in, ffn1_w_out, attn_norm, w_in, w_out,
              a_q_gain, a_k_gain, a_rel_bias, mem_norm, w_mem_kv, mem_q_gain, mem_k_gain,
              ffn2_norm, ffn2_w_in, ffn2_w_out):
    past = cache_b_k.shape[2]
    a_cache = cache_a_k.shape[2]
    n_dec, t_s = x_sample.shape[0], x_sample.shape[1]
    a_keep = min(BAND_PAST, x_prompt.shape[1])
    q_pos_s = past + jnp.arange(t_s)
    k_pos_a_s = jnp.concatenate([jnp.arange(past - a_cache, past), q_pos_s])
    sb_mask_s = jnp.arange(t_s)[None, :] < jnp.arange(t_s)[:, None]

    x_p, x_s = x_prompt, x_sample
    a_k_p, a_v_p, b_k_p, b_v_p, m_k_p, m_v_p = [], [], [], [], [], []
    a_k_s, a_v_s, b_k_s, b_v_s = [], [], [], []
    for l in range(DEPTH):
        j = l // 2
        x_p = x_p + _ffn(x_p, ffn1_norm[l], ffn1_w_in[l], ffn1_w_out[l])
        x_s = x_s + _ffn(x_s, ffn1_norm[l], ffn1_w_in[l], ffn1_w_out[l])
        if l % 2 == 0:
            qp, kp, vp, qmp = _project(x_p, attn_norm[l], w_in[l], A_HEADS, A_DIM)
            qs, ks_, vs, qms = _project(x_s, attn_norm[l], w_in[l], A_HEADS, A_DIM)
            qp, kp = _rms(qp, a_q_gain[j]) * (A_DIM ** -0.5), _rms(kp, a_k_gain[j])
            qs, ks_ = _rms(qs, a_q_gain[j]) * (A_DIM ** -0.5), _rms(ks_, a_k_gain[j])
            tok_p = _band_prompt(qp, kp, vp, a_rel_bias[j])
            k_all = jnp.concatenate([cache_a_k[j], ks_], axis=1)
            v_all = jnp.concatenate([cache_a_v[j], vs], axis=1)
            tok_s = _band_core(qs, k_all, v_all, _band_bias(a_rel_bias[j], q_pos_s, k_pos_a_s))
            a_k_p.append(kp[:, kp.shape[1] - a_keep:])
            a_v_p.append(vp[:, vp.shape[1] - a_keep:])
            a_k_s.append(ks_)
            a_v_s.append(vs)
        else:
            qp, kp, vp, qmp = _project(x_p, attn_norm[l], w_in[l], B_HEADS, B_DIM)
            qs, ks_, vs, qms = _project(x_s, attn_norm[l], w_in[l], B_HEADS, B_DIM)
            tok_p = _sb_prompt(qp * (B_DIM ** -0.5), kp, vp)
            kc = cache_b_k[j].reshape(n_dec, past // SB_BLOCK, SB_BLOCK, B_HEADS, B_DIM)
            vc = cache_b_v[j].reshape(n_dec, past // SB_BLOCK, SB_BLOCK, B_HEADS, B_DIM)
            tok_s = _sb_attend(qs * (B_DIM ** -0.5), kc, vc, ks_, vs, sb_mask_s)
            b_k_p.append(kp)
            b_v_p.append(vp)
            b_k_s.append(ks_)
            b_v_s.append(vs)
        mk_p, mv_p = _mem_kv(mem_prompt, mem_norm[l], w_mem_kv[l], mem_k_gain[l])
        m_k_p.append(mk_p)
        m_v_p.append(mv_p)
        mo_p = _mem_attn(qmp, mem_q_gain[l], mk_p, mv_p)
        mo_s = _mem_attn(qms, mem_q_gain[l], cache_mem_k[l], cache_mem_v[l])
        x_p = x_p + _merge(tok_p, mo_p, w_out[l])
        x_s = x_s + _merge(tok_s, mo_s, w_out[l])
        x_p = x_p + _ffn(x_p, ffn2_norm[l], ffn2_w_in[l], ffn2_w_out[l])
        x_s = x_s + _ffn(x_s, ffn2_norm[l], ffn2_w_in[l], ffn2_w_out[l])

    return (x_p, x_s,
            jnp.stack(a_k_p), jnp.stack(a_v_p), jnp.stack(b_k_p), jnp.stack(b_v_p),
            jnp.stack(m_k_p), jnp.stack(m_v_p),
            jnp.stack(a_k_s), jnp.stack(a_v_s), jnp.stack(b_k_s), jnp.stack(b_v_s))
```

```cpp
#include <hip/hip_runtime.h>
#include <cstdio>
#include <cstdint>
#include <cstring>
#ifndef MK_MULTI
#define MK_MULTI 0
#endif
#ifndef SB_EARLY
#define SB_EARLY 1
#endif
namespace pg8 {
#define PG8_LAS __attribute__((address_space(3)))
typedef unsigned short bf16_t;
typedef short bf16x8 __attribute__((ext_vector_type(8)));
typedef float f32x4 __attribute__((ext_vector_type(4)));
typedef unsigned u32x4 __attribute__((ext_vector_type(4)));
constexpr int BM = 256, BK = 64, HALF = 128, HTB = HALF * BK * 2  , STAGE_BYTES = 8 * HTB, NXCD = 8, WGM = 8;

__host__ __device__ __forceinline__ int lds_byte(int r, int c) { const int st = (r >> 4) * 2 + (c >> 5), rr = r & 15, cc = c & 31, ob = rr * 64 + cc * 2; return st * 1024 + (ob ^ (((ob >> 9) & 1) << 5)); }
__host__ __device__ __forceinline__ void stage_rc(int b, int& R, int& C) { const int st = b / 1024, sb = b % 1024, swz = sb ^ (((sb >> 9) & 1) << 5); R = (st >> 1) * 16 + swz / 64; C = (st & 1) * 32 + (swz % 64) / 2; }
__host__ __device__ __forceinline__ int perm32(int rho) { const int n = rho >> 4, i = rho & 15; return 8 * (i >> 2) + 4 * n + (i & 3); }

struct Unit { int pm, pn; };
struct Gemm { const bf16_t* A; const bf16_t* Bt; int M, N, K; };

struct StaticOrder {
    int nM, nN, nwg, G, c;
    __host__ __device__ void init(int M, int N, int G_, int c_) { nM = M / BM; nN = N / BM; nwg = nM * nN; G = G_; c = c_; }
    __host__ __device__ bool next(int i, Unit& u) const {
        const long L = (long)i * G + c; if (L >= nwg) return false;
        int wgid = (int)L; { const int q = nwg / NXCD, r = nwg % NXCD, xcd = wgid % NXCD, off = wgid / NXCD; wgid = (xcd < r ? xcd * (q + 1) : r * (q + 1) + (xcd - r) * q) + off; }
        const int nig = WGM * nN, gid = wgid / nig, fm = gid * WGM, gsz = (nM - fm) < WGM ? (nM - fm) : WGM;
        u.pm = fm + ((wgid % nig) % gsz); u.pn = (wgid % nig) / gsz; return true;
    }
    __device__ __forceinline__ void a_ready(const Unit&) const {}
    __device__ __forceinline__ void done(const Unit&) const {}
};

__device__ __forceinline__ unsigned cvt_pk_bf16(float lo, float hi) { unsigned r; asm volatile("v_cvt_pk_bf16_f32 %0, %1, %2" : "=v"(r) : "v"(lo), "v"(hi)); return r; }
typedef float f32x2 __attribute__((ext_vector_type(2)));
template <class Epi, class Sched, bool ALIGN_EPI = false, bool SP2 = false>
__device__ __forceinline__ void gemm_phase(PG8_LAS unsigned char* lds, const Gemm g, const Sched& S, const Epi& E) {
    int tid_ = threadIdx.x; asm volatile("" : "+v"(tid_));
    const int tid = tid_, wid = __builtin_amdgcn_readfirstlane(tid >> 6), lane = tid & 63, wr = wid >> 2, wc = wid & 3, fr = lane & 15, fq = lane >> 4;
    const int K = g.K, nt = K / BK;
    unsigned voffA[2], voffB[2];
#pragma unroll
    for (int i = 0; i < 2; ++i) { int R, C; stage_rc(tid * 16 + i * 8192, R, C); const int Rb = Epi::PERM ? ((R & ~31) + perm32(R & 31)) : R;
        voffA[i] = (unsigned)(R * K + C) * 2u; voffB[i] = (unsigned)(Rb * K + C) * 2u; }
    const size_t kstep = (size_t)(BK * 2);
    const size_t hstep = (size_t)HALF * K * 2;
    const size_t tstep = 2 * hstep;
    const unsigned ldsw = (unsigned)wid * 1024u;
    const int aoff = lds_byte(wr * 64 + fr, fq * 8), boff = lds_byte(wc * 32 + fr, fq * 8);
#define PG8_SA(b, h) (((b) * 2 + (h)) * HTB)
#define PG8_SB(b, h) ((4 + (b) * 2 + (h)) * HTB)
#define PG8_STAGE(bufoff, gbase, voff) do { _Pragma("unroll") for (int _i = 0; _i < 2; ++_i) \
        __builtin_amdgcn_global_load_lds((const unsigned*)((const char*)(gbase) + (voff)[_i]), (PG8_LAS unsigned*)(lds + (bufoff) + ldsw + _i * 8192), 16, 0, 0); } while (0)
#define PG8_LDA(dst, b, h) do { _Pragma("unroll") for (int m = 0; m < 4; ++m) _Pragma("unroll") for (int k = 0; k < 2; ++k) dst[m][k] = *(const PG8_LAS bf16x8*)(lds + PG8_SA(b, h) + aoff + m * 2048 + k * 1024); } while (0)
#define PG8_LDB(dst, b, h) do { _Pragma("unroll") for (int n = 0; n < 2; ++n) _Pragma("unroll") for (int k = 0; k < 2; ++k) dst[n][k] = *(const PG8_LAS bf16x8*)(lds + PG8_SB(b, h) + boff + n * 2048 + k * 1024); } while (0)
#define PG8_MMA(ai, bj, At, Bt) do { __builtin_amdgcn_s_setprio(1); _Pragma("unroll") for (int m = 0; m < 4; ++m) _Pragma("unroll") for (int n = 0; n < 2; ++n) _Pragma("unroll") for (int k = 0; k < 2; ++k) \
        acc[ai][bj][m][n] = __builtin_amdgcn_mfma_f32_16x16x32_bf16(Bt[n][k], At[m][k], acc[ai][bj][m][n], 0, 0, 0); __builtin_amdgcn_s_setprio(0); } while (0)
#define PG8_WAIT_V(n) asm volatile("s_waitcnt vmcnt(" #n ")" ::: "memory")
#define PG8_WAIT_L(n) asm volatile("s_waitcnt lgkmcnt(" #n ")" ::: "memory")
#define PG8_BAR __builtin_amdgcn_s_barrier()
#define PG8_SCHED __builtin_amdgcn_sched_barrier(0)
    Unit cur, nxt; int ui = 0;
    if (!S.next(0, cur)) return;
    f32x4 acc[2][2][4][2];
#pragma unroll
    for (int a = 0; a < 2; ++a)
#pragma unroll
        for (int b = 0; b < 2; ++b)
#pragma unroll
            for (int m = 0; m < 4; ++m)
#pragma unroll
                for (int n = 0; n < 2; ++n) acc[a][b][m][n] = (f32x4){0.f, 0.f, 0.f, 0.f};
    bf16x8 At[4][2], B0[2][2], B1[2][2];
    const char* cA = (const char*)g.A + (size_t)cur.pm * tstep; const char* cB = (const char*)g.Bt + (size_t)cur.pn * tstep;
    S.a_ready(cur);
    if constexpr (SP2) {
        PG8_STAGE(PG8_SB(0, 0), cB, voffB); PG8_STAGE(PG8_SB(0, 1), cB + hstep, voffB); PG8_STAGE(PG8_SA(0, 0), cA, voffA); PG8_STAGE(PG8_SA(0, 1), cA + hstep, voffA);
        if (wr == 1) PG8_BAR;
        PG8_WAIT_V(2); PG8_BAR;
        PG8_STAGE(PG8_SB(1, 0), cB + kstep, voffB); PG8_STAGE(PG8_SA(1, 0), cA + kstep, voffA); PG8_STAGE(PG8_SB(1, 1), cB + hstep + kstep, voffB);
        PG8_WAIT_V(6); PG8_BAR;
    } else {
        PG8_STAGE(PG8_SB(0, 0), cB, voffB); PG8_STAGE(PG8_SA(0, 0), cA, voffA); PG8_STAGE(PG8_SB(0, 1), cB + hstep, voffB); PG8_STAGE(PG8_SA(0, 1), cA + hstep, voffA);
        if (wr == 1) PG8_BAR;
        PG8_WAIT_V(4); PG8_BAR;
        PG8_STAGE(PG8_SB(1, 0), cB + kstep, voffB); PG8_STAGE(PG8_SA(1, 0), cA + kstep, voffA); PG8_STAGE(PG8_SB(1, 1), cB + hstep + kstep, voffB);
        PG8_WAIT_V(6); PG8_BAR;
    }
    for (;;) {
        const bool has_next = S.next(ui + 1, nxt);
        const char* nA = has_next ? (const char*)g.A + (size_t)nxt.pm * tstep : cA; const char* nB = has_next ? (const char*)g.Bt + (size_t)nxt.pn * tstep : cB;
        for (int t = 0; t < nt; t += 2) {
            const bool last = (t == nt - 2);
            const char* a1 = cA + (size_t)(t + 1) * kstep;
            const char* a2 = last ? nA : cA + (size_t)(t + 2) * kstep; const char* b2 = last ? nB : cB + (size_t)(t + 2) * kstep;
            const char* a3 = a2 + kstep; const char* b3 = b2 + kstep;
            if (last && has_next) S.a_ready(nxt);
            if constexpr (SP2) {
            PG8_LDB(B0, 0, 0); PG8_LDB(B1, 0, 1); PG8_SCHED; PG8_LDA(At, 0, 0); PG8_STAGE(PG8_SA(1, 1), a1 + hstep, voffA);
            PG8_WAIT_V(8); PG8_WAIT_L(0); PG8_BAR; PG8_MMA(0, 0, At, B0); PG8_MMA(0, 1, At, B1); PG8_BAR; PG8_SCHED;
            PG8_LDA(At, 0, 1); PG8_STAGE(PG8_SB(0, 0), b2, voffB); PG8_STAGE(PG8_SB(0, 1), b2 + hstep, voffB); PG8_STAGE(PG8_SA(0, 0), a2, voffA);
            PG8_WAIT_V(8); PG8_WAIT_L(0); PG8_BAR; PG8_MMA(1, 0, At, B0); PG8_MMA(1, 1, At, B1); PG8_BAR; PG8_SCHED;
            PG8_LDB(B0, 1, 0); PG8_LDB(B1, 1, 1); PG8_SCHED; PG8_LDA(At, 1, 0); PG8_STAGE(PG8_SA(0, 1), a2 + hstep, voffA);
            PG8_WAIT_V(8); PG8_WAIT_L(0); PG8_BAR; PG8_MMA(0, 0, At, B0); PG8_MMA(0, 1, At, B1); PG8_BAR; PG8_SCHED;
            PG8_LDA(At, 1, 1); PG8_STAGE(PG8_SB(1, 0), b3, voffB); PG8_STAGE(PG8_SB(1, 1), b3 + hstep, voffB); PG8_STAGE(PG8_SA(1, 0), a3, voffA);
            PG8_WAIT_V(8); PG8_WAIT_L(0); PG8_BAR; PG8_MMA(1, 0, At, B0); PG8_MMA(1, 1, At, B1); PG8_BAR; PG8_SCHED;
            } else {
            PG8_LDB(B0, 0, 0); PG8_SCHED; PG8_LDA(At, 0, 0); PG8_STAGE(PG8_SA(1, 1), a1 + hstep, voffA);
            PG8_WAIT_L(8); PG8_BAR; PG8_WAIT_L(0); PG8_MMA(0, 0, At, B0); PG8_BAR; PG8_SCHED;
            PG8_LDB(B1, 0, 1); PG8_STAGE(PG8_SB(0, 0), b2, voffB);
            PG8_BAR; PG8_WAIT_L(0); PG8_MMA(0, 1, At, B1); PG8_BAR;
            PG8_LDA(At, 0, 1); PG8_STAGE(PG8_SA(0, 0), a2, voffA);
            PG8_BAR; PG8_WAIT_L(0); PG8_MMA(1, 0, At, B0); PG8_BAR; PG8_SCHED;
            PG8_STAGE(PG8_SB(0, 1), b2 + hstep, voffB);
            PG8_WAIT_V(6); PG8_BAR; PG8_MMA(1, 1, At, B1); PG8_BAR;
            PG8_LDB(B0, 1, 0); PG8_SCHED; PG8_LDA(At, 1, 0); PG8_STAGE(PG8_SA(0, 1), a2 + hstep, voffA);
            PG8_WAIT_L(8); PG8_BAR; PG8_WAIT_L(0); PG8_MMA(0, 0, At, B0); PG8_BAR; PG8_SCHED;
            PG8_LDB(B1, 1, 1); PG8_STAGE(PG8_SB(1, 0), b3, voffB);
            PG8_BAR; PG8_WAIT_L(0); PG8_MMA(0, 1, At, B1); PG8_BAR;
            PG8_LDA(At, 1, 1); PG8_STAGE(PG8_SA(1, 0), a3, voffA);
            PG8_BAR; PG8_WAIT_L(0); PG8_MMA(1, 0, At, B0); PG8_BAR; PG8_SCHED;
            PG8_STAGE(PG8_SB(1, 1), b3 + hstep, voffB);
            PG8_WAIT_V(6); PG8_BAR; PG8_MMA(1, 1, At, B1); PG8_BAR;
            }
        }
        if constexpr (ALIGN_EPI) { if (wr == 0) PG8_BAR; }
        if constexpr (!Epi::AFTER_DRAIN) { E(acc, cur, wr, wc, fr, fq); S.done(cur); }
        if (!has_next) break;
#pragma unroll
        for (int a = 0; a < 2; ++a)
#pragma unroll
            for (int b = 0; b < 2; ++b)
#pragma unroll
                for (int m = 0; m < 4; ++m)
#pragma unroll
                    for (int n = 0; n < 2; ++n) acc[a][b][m][n] = (f32x4){0.f, 0.f, 0.f, 0.f};
        cur = nxt; cA = nA; cB = nB; ++ui;
        if constexpr (ALIGN_EPI) { if (wr == 1) PG8_BAR; }
    }
    PG8_WAIT_V(0);
    if constexpr (!ALIGN_EPI) { if (wr == 0) PG8_BAR; }
    PG8_BAR;
    if constexpr (Epi::AFTER_DRAIN) { E.fused(acc, cur, wr, wc, fr, fq, lds, wid, lane); S.done(cur); }
#undef PG8_SA
#undef PG8_SB
#undef PG8_STAGE
#undef PG8_LDA
#undef PG8_LDB
#undef PG8_MMA
#undef PG8_WAIT_V
#undef PG8_WAIT_L
#undef PG8_BAR
#undef PG8_SCHED
}
}


#define GAS __attribute__((address_space(1)))
#define LAS __attribute__((address_space(3)))
typedef unsigned short bf16;
typedef float f32x4 __attribute__((ext_vector_type(4)));
typedef short bf16x8 __attribute__((ext_vector_type(8)));
typedef short s16x4 __attribute__((ext_vector_type(4)));
typedef unsigned u32x4 __attribute__((ext_vector_type(4)));
typedef unsigned u32x2 __attribute__((ext_vector_type(2)));
constexpr int DM = 2048, DFF = 3072, SEQ = 16384, NB = 2, NP = NB * SEQ, DBAT = 32, DSEQ = 16, NS = DBAT * DSEQ, MR = NP + NS;
constexpr int NMEM = 256, NMR = NB * NMEM, MRX = MR + NMR;
constexpr int QKVW = 3584, AOW = 1536, INW = 4608, TOKW = 1024, MEMW = 512;
constexpr int PAST = 1024, ACACHE = 512, NLAYER = 4;
constexpr float EPS = 1e-6f;
constexpr int NPH = 1 + 7 * NLAYER;
constexpr size_t O_Y = 0, O_AKP = (size_t)MR * DM, O_AVP = O_AKP + 2097152, O_BKP = O_AVP + 2097152, O_BVP = O_BKP + 67108864, O_MKP = O_BVP + 67108864,
                 O_MVP = O_MKP + 1048576, O_AKS = O_MVP + 1048576, O_AVS = O_AKS + 1048576, O_BKS = O_AVS + 1048576, O_BVS = O_BKS + 1048576, O_END = O_BVS + 1048576;
static_assert(O_END == 212860928, "output size");
constexpr size_t MiB = 1u << 20;
constexpr size_t WS_CTL = 0, CTL_ZERO_BYTES = 1 * MiB;
constexpr size_t LW_1U = 0, LW_1D = LW_1U + (size_t)2 * DFF * DM * 2, LW_IN = LW_1D + (size_t)DM * DFF * 2, LW_O = LW_IN + (size_t)INW * DM * 2, LW_2U = LW_O + (size_t)DM * AOW * 2,
                 LW_2D = LW_2U + (size_t)2 * DFF * DM * 2, LW_SIZE = LW_2D + (size_t)DM * DFF * 2;
static_assert(LW_SIZE == 96 * MiB, "per-layer weight bytes");
constexpr size_t WS_W = 1 * MiB, WS_XB = WS_W + NLAYER * LW_SIZE, WS_H = WS_XB + 132 * MiB, WS_QKV = WS_H + 195 * MiB, WS_AO = WS_QKV + 228 * MiB, WS_MKV = WS_AO + 98 * MiB,
                 WS_SSQ = WS_MKV + 4 * MiB, WS_DBG = WS_SSQ + 3 * MiB, WS_END = WS_DBG + 1 * MiB;
static_assert((size_t)MRX * DM * 2 <= 132 * MiB && (size_t)MR * DFF * 2 <= 195 * MiB && (size_t)MR * QKVW * 2 <= 228 * MiB && (size_t)MR * AOW * 2 <= 98 * MiB, "ws map");
constexpr size_t SSQ_BUF = (size_t)MR * 8;
constexpr int RING_BYTES = 131072, TAB1_OFF = 131072  , TAB2_OFF = 135168  , MISC_OFF = 143360, LDS_BYTES = 147456;
constexpr int VT_STRIDE = 17408;
static_assert(8 * VT_STRIDE <= MISC_OFF, "lds map");

#define RLX_AGENT __ATOMIC_RELAXED, __HIP_MEMORY_SCOPE_AGENT
#define LDS_WAIT() asm volatile("s_waitcnt lgkmcnt(0)" ::: "memory")
#define VM_WAIT() asm volatile("s_waitcnt vmcnt(0)" ::: "memory")
__device__ __forceinline__ unsigned pkbf(float lo, float hi) { typedef float f2 __attribute__((ext_vector_type(2))); typedef __bf16 b2 __attribute__((ext_vector_type(2))); f2 v = {lo, hi}; b2 b = __builtin_convertvector(v, b2); return __builtin_bit_cast(unsigned, b); }
__device__ __forceinline__ float fexp(float x) { return __builtin_amdgcn_exp2f(x * 1.4426950408889634f); }
__device__ __forceinline__ float flog(float x) { return __builtin_amdgcn_logf(x) * 0.6931471805599453f; }
__device__ __forceinline__ float dot4(f32x4 a) { return (a.x * a.x + a.y * a.y) + (a.z * a.z + a.w * a.w); }
__device__ __forceinline__ float row_rscale(const float* ssq, int row) {
    const f32x4 a = *(const f32x4*)(ssq + (size_t)row * 8), b = *(const f32x4*)(ssq + (size_t)row * 8 + 4);
    return __builtin_amdgcn_rsqf(((a.x + a.y) + (a.z + a.w) + (b.x + b.y) + (b.z + b.w)) * (1.0f / DM) + EPS);
}
#define EPI_BAR() do { asm volatile("s_waitcnt lgkmcnt(0)" ::: "memory"); __builtin_amdgcn_s_barrier(); asm volatile("" ::: "memory"); } while (0)

typedef pg8::f32x4 acc_t[2][2][4][2];

struct EpiSwiGLU {
    static constexpr bool PERM = true, AFTER_DRAIN = false;
    bf16* H; const float* ssq;
    __device__ __forceinline__ void operator()(const acc_t& acc, const pg8::Unit& u, int wr, int wc, int fr, int fq) const {
        const int row0 = u.pm * 256 + wr * 64 + fr, col0 = u.pn * 128 + wc * 32 + 8 * fq;
#pragma unroll
        for (int ai = 0; ai < 2; ++ai)
#pragma unroll
            for (int m = 0; m < 4; ++m) {
                const int row = row0 + ai * 128 + m * 16; const float r = row_rscale(ssq, row);
                float hv[8];
#pragma unroll
                for (int n = 0; n < 2; ++n)
#pragma unroll
                    for (int e = 0; e < 4; ++e) { const float a = acc[ai][0][m][n][e] * r, b = acc[ai][1][m][n][e] * r;
                        hv[n * 4 + e] = a * __builtin_amdgcn_rcpf(1.0f + fexp(-a)) * b; }
                u32x4 w; w.x = pkbf(hv[0], hv[1]); w.y = pkbf(hv[2], hv[3]); w.z = pkbf(hv[4], hv[5]); w.w = pkbf(hv[6], hv[7]);
                *(u32x4*)(H + (size_t)row * DFF + col0) = w;
            }
    }
};

struct EpiResid {
    static constexpr bool PERM = true, AFTER_DRAIN = false;
    const float* base_p; const float* base_s;
    float* out; bf16* xb; float* ssq_out; LAS float* tab;
    __device__ __forceinline__ void operator()(const acc_t& acc, const pg8::Unit& u, int wr, int wc, int fr, int fq) const {
        const int rl0 = wr * 64 + fr, row0 = u.pm * 256 + rl0, col0 = u.pn * 256 + wc * 32 + 8 * fq;
        const float* base = (u.pm < NP / 256) ? base_p : (base_s - (size_t)NP * DM);
#pragma unroll
        for (int ai = 0; ai < 2; ++ai)
#pragma unroll
            for (int m = 0; m < 4; ++m) {
                const int row = row0 + ai * 128 + m * 16; float sq = 0.f;
#pragma unroll
                for (int bj = 0; bj < 2; ++bj) {
                    const size_t o = (size_t)row * DM + col0 + bj * 128;
                    const f32x4 x0 = *(const f32x4*)(base + o), x1 = *(const f32x4*)(base + o + 4);
                    const f32x4 v0 = x0 + acc[ai][bj][m][0], v1 = x1 + acc[ai][bj][m][1];
                    *(f32x4*)(out + o) = v0; *(f32x4*)(out + o + 4) = v1;
                    u32x4 w; w.x = pkbf(v0.x, v0.y); w.y = pkbf(v0.z, v0.w); w.z = pkbf(v1.x, v1.y); w.w = pkbf(v1.z, v1.w);
                    *(u32x4*)(xb + o) = w;
                    sq += dot4(v0) + dot4(v1);
                }
                sq += __shfl_xor(sq, 16); sq += __shfl_xor(sq, 32);
                if (fq == 0) tab[(rl0 + ai * 128 + m * 16) * 4 + wc] = sq;
            }
        EPI_BAR();
#pragma unroll
        for (int t = 0; t < 2; ++t) { const int g = wc * 2 + t, rl = (g >> 2) * 128 + (g & 3) * 16 + rl0;
            if (fq == 0) { const f32x4 p = *(const LAS f32x4*)(tab + rl * 4); ssq_out[(size_t)(u.pm * 256 + rl) * 8 + u.pn] = (p.x + p.y) + (p.z + p.w); } }
    }
};

struct EpiQKV {
    static constexpr bool PERM = true, AFTER_DRAIN = false;
    bf16* QKV; bf16* MKV; const float* ssq; const float* gains;
    float* out; int l;
    LAS float* tab2;
    __device__ __forceinline__ void operator()(const acc_t& acc, const pg8::Unit& u, int wr, int wc, int fr, int fq) const {
        const int pm = u.pm, pn = u.pn; const bool memrow = pm >= MR / 256; const int layerB = l & 1, j = l >> 1;
        const int rl0 = wr * 64 + fr, row0 = pm * 256 + rl0, cw = wc * 32 + 8 * fq;
        const int kind = memrow ? (pn < 16 ? 4 : 5) : (pn < 4 ? 0 : pn < 8 ? 1 : pn < 12 ? 2 : 3);
        const bool need_norm = (kind == 3) || (kind == 4) || (!layerB && kind <= 1);
        acc_t& va = const_cast<acc_t&>(acc);
#define VQ(ai, bj, m, e) va[ai][bj][m][(e) >> 2][(e) & 3]
        int zo = 0;
#pragma unroll
        for (int ai = 0; ai < 2; ++ai)
#pragma unroll
            for (int m = 0; m < 4; ++m) {
                asm volatile("" : "+s"(zo) :: "memory");
                const int rl = rl0 + ai * 128 + m * 16 + zo;
                const float r = memrow ? 1.0f : row_rscale(ssq, pm * 256 + rl);
#pragma unroll
                for (int bj = 0; bj < 2; ++bj) {
#pragma unroll
                    for (int n = 0; n < 2; ++n) va[ai][bj][m][n] *= r;
                    if (need_norm) { float sq = dot4(va[ai][bj][m][0]) + dot4(va[ai][bj][m][1]);
                        sq += __shfl_xor(sq, 16); sq += __shfl_xor(sq, 32);
                        if (fq == 0) tab2[(rl * 2 + bj) * 4 + wc] = sq; }
                }
            }
        float g[8];
        if (need_norm) {
            EPI_BAR();
            const float* gp = gains + ((kind == 0) ? 0 : (kind == 1) ? 128 : (kind == 3) ? 256 : 384);
            const float post = (kind == 0 || kind == 3) ? 0.08838834764831845f : 1.0f;
#pragma unroll
            for (int e = 0; e < 8; ++e) g[e] = gp[cw + e] * post;
        } else {
            const float post = (kind == 0) ? 0.0625f : 1.0f;
#pragma unroll
            for (int e = 0; e < 8; ++e) g[e] = post;
        }
        float* fo = nullptr; int fpitch = TOKW;
        const int ct = (kind == 1) ? (pn - 4) * 256 : (kind == 2) ? (pn - 8) * 256 : (kind == 4) ? (pn - 14) * 256 : (kind == 5) ? (pn - 16) * 256 : 0;
        if (kind == 1 || kind == 2) {
            const bool isk = kind == 1;
            if (pm >= NP / 256) fo = out + (layerB ? (isk ? O_BKS : O_BVS) : (isk ? O_AKS : O_AVS)) + (size_t)j * NS * TOKW + (size_t)(pm * 256 - NP) * TOKW;
            else if (layerB) fo = out + (isk ? O_BKP : O_BVP) + (size_t)j * NP * TOKW + (size_t)(pm * 256) * TOKW;
            else if ((pm & 63) >= 62) fo = out + (isk ? O_AKP : O_AVP) + (size_t)j * NB * 512 * TOKW + (size_t)((pm >> 6) * 512 + ((pm & 63) - 62) * 256) * TOKW;
        } else if (kind >= 4) { fo = out + (kind == 4 ? O_MKP : O_MVP) + (size_t)l * NMR * MEMW + (size_t)(pm * 256 - MR) * MEMW; fpitch = MEMW; }
        if (fo) fo += ct + cw;
        bf16* bo = memrow ? MKV + (size_t)(pm * 256 - MR) * 1024 + (pn - 14) * 256 + cw : QKV + (size_t)(pm * 256) * QKVW + pn * 256 + cw;
        const int bpitch = memrow ? 1024 : QKVW;
#pragma unroll
        for (int ai = 0; ai < 2; ++ai)
#pragma unroll
            for (int m = 0; m < 4; ++m) {
                asm volatile("" : "+s"(zo) :: "memory");
                const int rl = rl0 + ai * 128 + m * 16 + zo;
#pragma unroll
                for (int bj = 0; bj < 2; ++bj) {
                    float rn = 1.0f;
                    if (need_norm) { const f32x4 p = *(const LAS f32x4*)(tab2 + (rl * 2 + bj) * 4); rn = __builtin_amdgcn_rsqf(((p.x + p.y) + (p.z + p.w)) * (1.0f / 128.0f) + EPS); }
#pragma unroll
                    for (int e = 0; e < 8; ++e) VQ(ai, bj, m, e) *= rn * g[e];
                    const f32x4 x0 = va[ai][bj][m][0], x1 = va[ai][bj][m][1];
                    u32x4 w; w.x = pkbf(x0.x, x0.y); w.y = pkbf(x0.z, x0.w); w.z = pkbf(x1.x, x1.y); w.w = pkbf(x1.z, x1.w);
                    *(u32x4*)(bo + (size_t)rl * bpitch + bj * 128) = w;
                    if (fo) { float* p = fo + (size_t)rl * fpitch + bj * 128; *(f32x4*)p = x0; *(f32x4*)(p + 4) = x1; }
                }
            }
    }
};
#undef VQ
struct G3Order {
    pg8::StaticOrder so; int G, c;
    __device__ void init(int G_, int c_) { so.init(MR, QKVW, G_, c_); G = G_; c = c_; }
    __device__ bool next(int i, pg8::Unit& u) const {
        const long L = (long)i * G + c;
        if (L < so.nwg) return so.next(i, u);
        const int j = (int)(L - so.nwg); if (j >= 8) return false;
        u.pm = MR / 256 + (j >> 2); u.pn = 14 + (j & 3); return true;
    }
    __device__ __forceinline__ void a_ready(const pg8::Unit&) const {}
    __device__ __forceinline__ void done(const pg8::Unit&) const {}
};
#define XB_TMO      128
#define XB_XCNT(j)  (256  + 64 * (j))
#define XB_XSUB(j)  (1280 + 64 * (j))
#define XB_XGEN(j)  (2304 + 64 * (j))
#define XB_TOP      3328
#define XB_TOPGEN   3392
#define XCD_BAR_WORDS 3456
#define XB_SPIN_CAP (1u << 18)

__device__ __forceinline__ unsigned xb_ld(unsigned* p)              { return __hip_atomic_load(p, __ATOMIC_RELAXED, __HIP_MEMORY_SCOPE_AGENT); }
__device__ __forceinline__ unsigned xb_add(unsigned* p, unsigned v) { return __hip_atomic_fetch_add(p, v, __ATOMIC_RELAXED, __HIP_MEMORY_SCOPE_AGENT); }
__device__ __forceinline__ unsigned xb_xcc_id() { return (unsigned)__builtin_amdgcn_s_getreg((3 << 11) | 20) & 0xFu; }
#define XB_SPIN(cond, bar) do { unsigned _sp = 0; while (cond) { __builtin_amdgcn_s_sleep(1); \
    if ((++_sp & 255u) == 0u) { if (xb_ld(&(bar)[XB_TMO])) break; if (_sp > XB_SPIN_CAP) { atomicAdd(&(bar)[XB_TMO], 1u); break; } } } } while (0)

struct XcdBarrier {
    unsigned* bar; unsigned x;
    volatile LAS unsigned* st;
};

__device__ __forceinline__ XcdBarrier xcd_barrier_post(unsigned* bar, volatile LAS unsigned* st) {
    XcdBarrier b; b.bar = bar; b.x = xb_xcc_id(); b.st = st;
    if (threadIdx.x == 0) (void)xb_add(&bar[XB_XCNT(b.x)], 1u);
    return b;
}
__device__ __forceinline__ void xcd_barrier_complete(unsigned* bar, unsigned x, unsigned& nloc, unsigned& nx) {
    const unsigned G = gridDim.x * gridDim.y * gridDim.z;
    unsigned sum, cnt, mine, sp = 0u;
    for (;;) {
        sum = 0u; cnt = 0u; mine = 0u;
#pragma unroll
        for (unsigned j = 0; j < 16; ++j) { const unsigned c = xb_ld(&bar[XB_XCNT(j)]); sum += c; cnt += (c > 0u) ? 1u : 0u; mine = (j == x) ? c : mine; }
        if (sum == G) break;
        __builtin_amdgcn_s_sleep(1);
        if ((++sp & 255u) == 0u) { if (xb_ld(&bar[XB_TMO])) break; if (sp > XB_SPIN_CAP) { atomicAdd(&bar[XB_TMO], 1u); break; } }
    }
    nloc = mine > 0u ? mine : 1u; nx = cnt > 0u ? cnt : 1u;
}

__device__ __forceinline__ void xcd_barrier(const XcdBarrier& b) {
    asm volatile("s_waitcnt vmcnt(0)" ::: "memory");
    __syncthreads();
    if (threadIdx.x == 0) {
        unsigned* bar = b.bar;
        __builtin_amdgcn_s_waitcnt(0);
        unsigned nloc = b.st[0], nx = b.st[1];
        if (nloc == 0u) { xcd_barrier_complete(bar, b.x, nloc, nx); b.st[0] = nloc; b.st[1] = nx; }
        const unsigned old = xb_add(&bar[XB_XSUB(b.x)], 1u);
        const unsigned gen = old / nloc;
        if (old + 1u == (gen + 1u) * nloc) {
            __builtin_amdgcn_fence(__ATOMIC_RELEASE, "agent");
            asm volatile("s_waitcnt vmcnt(0)" ::: "memory");
            const unsigned og = xb_add(&bar[XB_TOP], 1u);
            const unsigned tg = og / nx;
            if (og + 1u == (tg + 1u) * nx) xb_add(&bar[XB_TOPGEN], 1u);
            else XB_SPIN(xb_ld(&bar[XB_TOPGEN]) == tg, bar);
            __builtin_amdgcn_fence(__ATOMIC_ACQUIRE, "agent");
            xb_add(&bar[XB_XGEN(b.x)], 1u);
            asm volatile("s_waitcnt vmcnt(0)" ::: "memory");
        } else {
            XB_SPIN(xb_ld(&bar[XB_XGEN(b.x)]) == gen, bar);
            __builtin_amdgcn_fence(__ATOMIC_ACQUIRE, "agent");
            asm volatile("s_waitcnt vmcnt(0)" ::: "memory");
        }
    }
    __syncthreads();
}


namespace att {
#define MFMA16(a, b, c) __builtin_amdgcn_mfma_f32_16x16x32_bf16((a), (b), (c), 0, 0, 0)
typedef short v4i16_t __attribute__((ext_vector_type(4)));
__device__ __forceinline__ s16x4 vtr(const LAS char* p) { return __builtin_bit_cast(s16x4, __builtin_amdgcn_ds_read_tr16_b64_v4i16((LAS v4i16_t*)p)); }

template <bool F32> __device__ __forceinline__ bf16x8 ld8(const char* rowp, int col) {
    if constexpr (F32) { const f32x4 a = *(const f32x4*)(rowp + (size_t)col * 4), b = *(const f32x4*)(rowp + (size_t)col * 4 + 16);
        u32x4 w; w.x = pkbf(a.x, a.y); w.y = pkbf(a.z, a.w); w.z = pkbf(b.x, b.y); w.w = pkbf(b.z, b.w); return __builtin_bit_cast(bf16x8, w); }
    else return *(const bf16x8*)(rowp + (size_t)col * 2);
}
template <int HD, int QB> __device__ __forceinline__ void load_q(bf16x8 (&qf)[QB][HD / 32], const bf16* q  , int fr, int fq) {
#pragma unroll
    for (int qb = 0; qb < QB; ++qb)
#pragma unroll
        for (int ks = 0; ks < HD / 32; ++ks) qf[qb][ks] = *(const bf16x8*)(q + (size_t)(16 * qb + fr) * QKVW + 32 * ks + 8 * fq);
}
template <int HD, int QB, bool F32> __device__ __forceinline__ void qk_tile(f32x4 (&s)[2][QB], const bf16x8 (&qf)[QB][HD / 32], const char* kbase, size_t pitchB, int key0, int kmax, int fr, int fq) {
#pragma unroll
    for (int u = 0; u < 2; ++u) {
        int row = key0 + 16 * u + fr; row = row < kmax ? row : kmax;
        const char* rp = kbase + (size_t)row * pitchB;
        bf16x8 kf[HD / 32];
#pragma unroll
        for (int ks = 0; ks < HD / 32; ++ks) kf[ks] = ld8<F32>(rp, 32 * ks + 8 * fq);
#pragma unroll
        for (int qb = 0; qb < QB; ++qb) { f32x4 a = {0.f, 0.f, 0.f, 0.f};
#pragma unroll
            for (int ks = 0; ks < HD / 32; ++ks) a = MFMA16(kf[ks], qf[qb][ks], a);
            s[u][qb] = a; }
    }
}
template <int HD, bool F32> __device__ __forceinline__ void stage_v(LAS char* vt, const char* vbase, size_t pitchB, int key0, int kmax, int lane) {
    constexpr int CPR = HD / 8, PITCH = HD * 2 + 32;
#pragma unroll
    for (int i = 0; i < 32 * CPR / 64; ++i) { const int n = lane + 64 * i, row = n / CPR, ch = n % CPR; int grow = key0 + row; grow = grow < kmax ? grow : kmax;
        const bf16x8 v = ld8<F32>(vbase + (size_t)grow * pitchB, ch * 8);
        *(LAS bf16x8*)(vt + row * PITCH + ch * 16) = v; }
}
template <int HD, int QB> __device__ __forceinline__ void pv_tile(f32x4 (&o)[HD / 16][QB], const bf16x8 (&pf)[QB], const LAS char* vt, int lane) {
    constexpr int PITCH = HD * 2 + 32;
    const int fq = lane >> 4, q = (lane & 15) >> 2, p = lane & 3;
    const LAS char* base = vt + (4 * fq + q) * PITCH + p * 8;
#pragma unroll
    for (int c = 0; c < HD / 16; ++c) {
        const s16x4 lo = vtr(base + c * 32), hi = vtr(base + 16 * PITCH + c * 32);
        const bf16x8 vf = __builtin_shufflevector(lo, hi, 0, 1, 2, 3, 4, 5, 6, 7);
#pragma unroll
        for (int qb = 0; qb < QB; ++qb) o[c][qb] = MFMA16(vf, pf[qb], o[c][qb]);
    }
}
__device__ __forceinline__ bf16x8 pack8(const f32x4& a, const f32x4& b) { u32x4 w; w.x = pkbf(a.x, a.y); w.y = pkbf(a.z, a.w); w.z = pkbf(b.x, b.y); w.w = pkbf(b.z, b.w); return __builtin_bit_cast(bf16x8, w); }

template <int HD, int QB> __device__ __forceinline__ void softmax_step(f32x4 (&s)[2][QB], const unsigned (&vmask)[QB], float (&m)[QB], float (&l)[QB], f32x4 (&o)[HD / 16][QB], bf16x8 (&pf)[QB]) {
#pragma unroll
    for (int qb = 0; qb < QB; ++qb) {
        float mx = -1e30f;
#pragma unroll
        for (int u = 0; u < 2; ++u)
#pragma unroll
            for (int i = 0; i < 4; ++i) { const bool ok = (vmask[qb] >> (4 * u + i)) & 1u; s[u][qb][i] = ok ? s[u][qb][i] : -1e30f; mx = fmaxf(mx, s[u][qb][i]); }
        mx = fmaxf(mx, __shfl_xor(mx, 16)); mx = fmaxf(mx, __shfl_xor(mx, 32));
        const float mn = fmaxf(m[qb], mx), alpha = fexp(m[qb] - mn);
        float ps = 0.f;
#pragma unroll
        for (int u = 0; u < 2; ++u)
#pragma unroll
            for (int i = 0; i < 4; ++i) { const bool ok = (vmask[qb] >> (4 * u + i)) & 1u; const float p = ok ? fexp(s[u][qb][i] - mn) : 0.f; s[u][qb][i] = p; ps += p; }
        l[qb] = l[qb] * alpha + ps; m[qb] = mn;
#pragma unroll
        for (int c = 0; c < HD / 16; ++c) o[c][qb] *= alpha;
        pf[qb] = pack8(s[0][qb], s[1][qb]);
    }
}
__device__ __forceinline__ void stick_step(f32x4 (&s)[2][1], unsigned vmask, float& R, bf16x8& pf, int fq) {
    float sp[2][4], suf[2][4], tot[2], later[2];
#pragma unroll
    for (int u = 0; u < 2; ++u) {
#pragma unroll
        for (int i = 0; i < 4; ++i) { const bool ok = (vmask >> (4 * u + i)) & 1u; const float z = s[u][0][i];
            sp[u][i] = ok ? (fmaxf(z, 0.f) + flog(1.0f + fexp(-fabsf(z)))) : 0.f; }
        suf[u][3] = sp[u][3]; suf[u][2] = sp[u][2] + suf[u][3]; suf[u][1] = sp[u][1] + suf[u][2]; suf[u][0] = sp[u][0] + suf[u][1];
        const float T = suf[u][0], t1 = __shfl_xor(T, 16), t2 = __shfl_xor(T, 32), t3 = __shfl_xor(T, 48);
        later[u] = ((fq ^ 1) > fq ? t1 : 0.f) + ((fq ^ 2) > fq ? t2 : 0.f) + ((fq ^ 3) > fq ? t3 : 0.f);
        tot[u] = (T + t1) + (t2 + t3);
    }
    f32x4 w[2];
#pragma unroll
    for (int i = 0; i < 4; ++i) {
        const bool ok1 = (vmask >> (4 + i)) & 1u, ok0 = (vmask >> i) & 1u;
        w[1][i] = ok1 ? fexp(s[1][0][i] - (R + later[1] + suf[1][i])) : 0.f;
        w[0][i] = ok0 ? fexp(s[0][0][i] - (R + tot[1] + later[0] + suf[0][i])) : 0.f;
    }
    R += tot[0] + tot[1];
    pf = pack8(w[0], w[1]);
}
template <int HD, int QB> __device__ __forceinline__ void store_o(const f32x4 (&o)[HD / 16][QB], const float (&inv)[QB], bf16* ao  , int nq, int fr, int fq) {
    asm volatile("" : "+v"(fr), "+v"(fq));
#pragma unroll
    for (int qb = 0; qb < QB; ++qb)
#pragma unroll
        for (int c = 0; c < HD / 16; ++c) { const f32x4 x = o[c][qb] * inv[qb]; u32x2 w; w.x = pkbf(x.x, x.y); w.y = pkbf(x.z, x.w);
            if (16 * qb + fr < nq) *(u32x2*)(ao + (size_t)(16 * qb + fr) * AOW + 16 * c + 4 * fq) = w; }
}

template <int QB> __device__ __forceinline__ void bias_and_mask(f32x4 (&s)[2][QB], unsigned (&vmask)[QB], const float* relb, int qpos0, int key0, int nvalid, int kpos, int fr, int fq) {
#pragma unroll
    for (int qb = 0; qb < QB; ++qb) { unsigned vm = 0u;
#pragma unroll
        for (int u = 0; u < 2; ++u)
#pragma unroll
            for (int i = 0; i < 4; ++i) { const int kk = key0 + 16 * u + 4 * fq + i; if (kk < nvalid) vm |= 1u << (4 * u + i);
                if (relb) { int rel = (qpos0 + 16 * qb + fr) - (kpos + kk); rel = rel < -128 ? -128 : (rel > 128 ? 128 : rel); s[u][qb][i] += relb[rel + 128]; } }
        vmask[qb] = vm; }
}
template <int QB, bool SEG1>
__device__ __forceinline__ void softmax_item(const bf16* q, int qpos0, bf16* ao,
                                             const char* k1, const char* v1, size_t pitch1, int n1, int kpos1,
                                             const char* k2, const char* v2, size_t pitch2, int k2lo, int k2hi, int n2, int kpos2,
                                             const float* relb, LAS char* vt, int lane) {
    constexpr int HD = 128;
    const int fr = lane & 15, fq = lane >> 4;
    bf16x8 qf[QB][HD / 32]; load_q<HD, QB>(qf, q, fr, fq);
    f32x4 o[HD / 16][QB]; float m[QB], l[QB];
#pragma unroll
    for (int qb = 0; qb < QB; ++qb) { m[qb] = -1e30f; l[qb] = 0.f;
#pragma unroll
        for (int c = 0; c < HD / 16; ++c) o[c][qb] = (f32x4){0.f, 0.f, 0.f, 0.f}; }
    f32x4 s[2][QB]; bf16x8 pf[QB]; unsigned vmask[QB];
    if constexpr (SEG1) {
        for (int key0 = 0; key0 < n1; key0 += 32) {
            qk_tile<HD, QB, true>(s, qf, k1, pitch1, key0, n1 - 1, fr, fq);
            stage_v<HD, true>(vt, v1, pitch1, key0, n1 - 1, lane);
            bias_and_mask<QB>(s, vmask, relb, qpos0, key0, n1, kpos1, fr, fq);
            softmax_step<HD, QB>(s, vmask, m, l, o, pf);
            pv_tile<HD, QB>(o, pf, vt, lane);
        }
    }
    for (int key0 = k2lo; key0 < k2hi; key0 += 32) {
        qk_tile<HD, QB, false>(s, qf, k2, pitch2, key0, n2 - 1, fr, fq);
        stage_v<HD, false>(vt, v2, pitch2, key0, n2 - 1, lane);
        bias_and_mask<QB>(s, vmask, relb, qpos0, key0, n2, kpos2, fr, fq);
        softmax_step<HD, QB>(s, vmask, m, l, o, pf);
        pv_tile<HD, QB>(o, pf, vt, lane);
    }
    float inv[QB];
#pragma unroll
    for (int qb = 0; qb < QB; ++qb) { float t = l[qb]; t += __shfl_xor(t, 16); t += __shfl_xor(t, 32); inv[qb] = 1.0f / t; }
    store_o<HD, QB>(o, inv, ao, 16 * QB, fr, fq);
}

template <bool SEG1>
__device__ __forceinline__ void stick_item(const bf16* q, int q0, bf16* ao,
                                           const char* k1, const char* v1, size_t pitch1, int n1,
                                           const char* k2, const char* v2, size_t pitch2, int n2,
                                           LAS char* vt, int lane) {
    constexpr int HD = 256;
    const int fr = lane & 15, fq = lane >> 4;
    bf16x8 qf[1][HD / 32]; load_q<HD, 1>(qf, q, fr, fq);
    f32x4 o[HD / 16][1];
#pragma unroll
    for (int c = 0; c < HD / 16; ++c) o[c][0] = (f32x4){0.f, 0.f, 0.f, 0.f};
    float R = 0.f; f32x4 s[2][1]; bf16x8 pf[1]; bool done = false;
    for (int key0 = (q0 >> 5) << 5; key0 >= 0; key0 -= 32) {
        qk_tile<HD, 1, false>(s, qf, k2, pitch2, key0, n2 - 1, fr, fq);
        stage_v<HD, false>(vt, v2, pitch2, key0, n2 - 1, lane);
        unsigned vm = 0u;
#pragma unroll
        for (int u = 0; u < 2; ++u)
#pragma unroll
            for (int i = 0; i < 4; ++i) { const int kk = key0 + 16 * u + 4 * fq + i; if (kk < n2 && kk < q0 + fr) vm |= 1u << (4 * u + i); }
        stick_step(s, vm, R, pf[0], fq);
        pv_tile<HD, 1>(o, pf, vt, lane);
#if SB_EARLY
        if (__all(R > 110.0f)) { done = true; break; }
#endif
    }
    if constexpr (SEG1) {
        if (!done) for (int key0 = n1 - 32; key0 >= 0; key0 -= 32) {
            qk_tile<HD, 1, true>(s, qf, k1, pitch1, key0, n1 - 1, fr, fq);
            stage_v<HD, true>(vt, v1, pitch1, key0, n1 - 1, lane);
            stick_step(s, 0xffu, R, pf[0], fq);
            pv_tile<HD, 1>(o, pf, vt, lane);
#if SB_EARLY
            if (__all(R > 110.0f)) break;
#endif
        }
    }
    const float inv[1] = {1.0f};
    store_o<HD, 1>(o, inv, ao, 16, fr, fq);
}
}

__device__ __forceinline__ void p0_transpose_item(const float* W, int K, int N, bf16* WT, const float* gain, float scale, int ffn_up, LAS float* scr, int item, int lane) {
    const int nblk = N / 32, kb = item / nblk, nb = item % nblk, k0 = 64 * kb, n0 = 32 * nb;
    int r0 = n0;
    if (ffn_up) { const int j0 = n0 < DFF ? n0 : n0 - DFF; r0 = 256 * (j0 >> 7) + (n0 < DFF ? 0 : 128) + (j0 & 127); }
#pragma unroll 8
    for (int i = 0; i < 32; ++i) { const int kk = 2 * i + (lane >> 5); const float g = gain ? gain[k0 + kk] * scale : scale;
        scr[kk * 33 + (lane & 31)] = W[(size_t)(k0 + kk) * N + n0 + (lane & 31)] * g; }
    LDS_WAIT(); asm volatile("" ::: "memory");
    const int c = lane & 7;
#pragma unroll
    for (int j = 0; j < 4; ++j) { const int n = (lane >> 3) + 8 * j; const LAS float* s = scr + (8 * c) * 33 + n;
        u32x4 o; o.x = pkbf(s[0 * 33], s[1 * 33]); o.y = pkbf(s[2 * 33], s[3 * 33]); o.z = pkbf(s[4 * 33], s[5 * 33]); o.w = pkbf(s[6 * 33], s[7 * 33]);
        *(u32x4*)(WT + (size_t)(r0 + n) * K + k0 + 8 * c) = o; }
    LDS_WAIT(); asm volatile("" ::: "memory");
}
__device__ __forceinline__ float wave_sum(float v) {
#pragma unroll
    for (int o = 1; o < 64; o <<= 1) v += __shfl_xor(v, o);
    return v;
}
__device__ __forceinline__ void p0_row(const float* xrow, bf16* orow, float* ssq_row, int norm, int lane) {
    const f32x4* xr = (const f32x4*)xrow + lane;
    f32x4 v[8]; float s = 0.f;
#pragma unroll
    for (int j = 0; j < 8; ++j) { v[j] = xr[64 * j]; s += dot4(v[j]); }
    s = wave_sum(s);
    const float sc = norm ? __builtin_amdgcn_rsqf(s * (1.0f / DM) + EPS) : 1.0f;
    u32x2* o8 = (u32x2*)orow + lane;
#pragma unroll
    for (int j = 0; j < 8; ++j) { u32x2 w; w.x = pkbf(v[j].x * sc, v[j].y * sc); w.y = pkbf(v[j].z * sc, v[j].w * sc); o8[64 * j] = w; }
    if (ssq_row && lane < 8) ssq_row[lane] = lane == 0 ? s : 0.f;
}

struct Params { const float* in[25]; float* out; unsigned char* ws; int ph_lo, ph_hi, bar_idx, pad; };
__global__ void __launch_bounds__(512, 2) fwd(Params P) {
    extern __shared__ __attribute__((aligned(16))) unsigned char lds_raw[];
    LAS unsigned char* lds = (LAS unsigned char*)lds_raw;
    const int tid = threadIdx.x, lane = tid & 63, wave = __builtin_amdgcn_readfirstlane(tid >> 6);
    const int G = gridDim.x, gw = blockIdx.x * 8 + wave, NGW = G * 8;
    unsigned char* ws = P.ws; float* out = P.out;
    volatile LAS unsigned* MISC = (volatile LAS unsigned*)(lds + MISC_OFF);
    if (tid < 32) MISC[tid] = 0u;
    __syncthreads();
    unsigned* ctl = (unsigned*)(ws + WS_CTL);
    XcdBarrier bar; bar.bar = ctl + 4096; bar.x = 0; bar.st = nullptr;
    if (!MK_MULTI) bar = xcd_barrier_post(ctl + 4096, MISC + 8);
    const int lo = P.ph_lo, hi = P.ph_hi;
#define IN(k) (lo <= (k) && (k) < hi)
#define SEAM(k) do { if (IN(k) && IN((k) + 1)) xcd_barrier(bar); } while (0)
    bf16* XB = (bf16*)(ws + WS_XB); bf16* HB = (bf16*)(ws + WS_H); bf16* QKV = (bf16*)(ws + WS_QKV); bf16* AO = (bf16*)(ws + WS_AO); bf16* MKV = (bf16*)(ws + WS_MKV);
    float* SSQ = (float*)(ws + WS_SSQ);
    LAS float* TAB1 = (LAS float*)(lds + TAB1_OFF); LAS float* TAB2 = (LAS float*)(lds + TAB2_OFF);

    if (IN(0)) {
        LAS float* scr = (LAS float*)(lds + wave * 16384);
        constexpr int I_U = (DM / 64) * (2 * DFF / 32), I_D = (DFF / 64) * (DM / 32), I_IN = (DM / 64) * (QKVW / 32), I_MK = (DM / 64) * (1024 / 32), I_O = (AOW / 64) * (DM / 32);
        constexpr int I_LAYER = 2 * I_U + 2 * I_D + I_IN + I_MK + I_O, I_W = NLAYER * I_LAYER, I_ALL = I_W + MRX;
        for (int it = gw; it < I_ALL; it += NGW) {
            if (it < I_W) {
                const int l = it / I_LAYER; int r = it % I_LAYER;
                bf16* LW = (bf16*)(ws + WS_W + (size_t)l * LW_SIZE);
                if (r < I_U) { p0_transpose_item(P.in[10] + (size_t)l * DM * 2 * DFF, DM, 2 * DFF, (bf16*)((char*)LW + LW_1U), P.in[9] + l * DM, 1.0f, 1, scr, r, lane); continue; } r -= I_U;
                if (r < I_D) { p0_transpose_item(P.in[11] + (size_t)l * DFF * DM, DFF, DM, (bf16*)((char*)LW + LW_1D), nullptr, 0.5f, 0, scr, r, lane); continue; } r -= I_D;
                if (r < I_IN) { p0_transpose_item(P.in[13] + (size_t)l * DM * QKVW, DM, QKVW, (bf16*)((char*)LW + LW_IN), P.in[12] + l * DM, 1.0f, 0, scr, r, lane); continue; } r -= I_IN;
                if (r < I_MK) { p0_transpose_item(P.in[19] + (size_t)l * DM * 1024, DM, 1024, (bf16*)((char*)LW + LW_IN) + (size_t)QKVW * DM, P.in[18] + l * DM, 1.0f, 0, scr, r, lane); continue; } r -= I_MK;
                if (r < I_O) { p0_transpose_item(P.in[14] + (size_t)l * AOW * DM, AOW, DM, (bf16*)((char*)LW + LW_O), nullptr, 1.0f, 0, scr, r, lane); continue; } r -= I_O;
                if (r < I_U) { p0_transpose_item(P.in[23] + (size_t)l * DM * 2 * DFF, DM, 2 * DFF, (bf16*)((char*)LW + LW_2U), P.in[22] + l * DM, 1.0f, 1, scr, r, lane); continue; } r -= I_U;
                p0_transpose_item(P.in[24] + (size_t)l * DFF * DM, DFF, DM, (bf16*)((char*)LW + LW_2D), nullptr, 0.5f, 0, scr, r, lane);
            } else {
                const int m = it - I_W;
                const float* src = m < NP ? P.in[0] + (size_t)m * DM : m < MR ? P.in[1] + (size_t)(m - NP) * DM : P.in[2] + (size_t)(m - MR) * DM;
                p0_row(src, XB + (size_t)m * DM, m < MR ? SSQ + (size_t)m * 8 : nullptr, m >= MR, lane);
            }
        }
    }
    if (IN(0) && blockIdx.x == 0) {
        float* gd = (float*)(ws + WS_DBG);
        for (int i = tid; i < NLAYER * 512; i += 512) { const int l = i >> 9, k = (i >> 7) & 3, d = i & 127;
            gd[i] = k == 0 ? P.in[15][(l >> 1) * 128 + d] : k == 1 ? P.in[16][(l >> 1) * 128 + d] : k == 2 ? P.in[20][l * 128 + d] : P.in[21][l * 128 + d]; }
    }
    SEAM(0);

    for (int l = 0; l < NLAYER; ++l) {
        const int pb = 1 + 7 * l, e = l & 1, j = l >> 1;
        if (hi <= pb || lo >= pb + 7) continue;
        const char* LW = (const char*)(ws + WS_W + (size_t)l * LW_SIZE);
        float* ssqA = SSQ + (size_t)e * SSQ_BUF; float* ssqB = SSQ + (size_t)(1 - e) * SSQ_BUF;
        if (IN(pb + 0)) {
            pg8::Gemm g{XB, (const bf16*)(LW + LW_1U), MR, 2 * DFF, DM}; pg8::StaticOrder S; int bx = blockIdx.x; asm volatile("" : "+s"(bx)); S.init(MR, 2 * DFF, G, bx);
            EpiSwiGLU E{HB, ssqA};
            pg8::gemm_phase<EpiSwiGLU, pg8::StaticOrder, true, true>(lds, g, S, E);
        }
        SEAM(pb + 0);
        if (IN(pb + 1)) {
            pg8::Gemm g{HB, (const bf16*)(LW + LW_1D), MR, DM, DFF}; pg8::StaticOrder S; int bx = blockIdx.x; asm volatile("" : "+s"(bx)); S.init(MR, DM, G, bx);
            EpiResid E{l == 0 ? P.in[0] : out, l == 0 ? P.in[1] : out + (size_t)NP * DM, out, XB, ssqB, TAB1};
            pg8::gemm_phase<EpiResid, pg8::StaticOrder, true, true>(lds, g, S, E);
        }
        SEAM(pb + 1);
        if (IN(pb + 2)) {
            pg8::Gemm g{XB, (const bf16*)(LW + LW_IN), MRX, INW, DM}; G3Order S; int bx = blockIdx.x; asm volatile("" : "+s"(bx)); S.init(G, bx);
            EpiQKV E{QKV, MKV + (size_t)l * NMR * 1024, ssqB, (const float*)(ws + WS_DBG) + l * 512, out, l, TAB2};
            pg8::gemm_phase<EpiQKV, G3Order, true, true>(lds, g, S, E);
        }
        SEAM(pb + 2);
        if (IN(pb + 3)) {
            int lane_ = lane; asm volatile("" : "+v"(lane_)); __builtin_assume(lane_ >= 0 && lane_ < 64);
            const int lane = lane_;
            LAS char* vt = (LAS char*)lds + wave * VT_STRIDE;
            const bf16* mkv = MKV + (size_t)l * NMR * 1024;
            if (!e) {
                const float* relb = P.in[17] + (size_t)j * 8 * 257;
                for (int it = gw; it < NB * 8 * (SEQ / 32); it += NGW) {
                    const int qblk = it % (SEQ / 32), h = (it / (SEQ / 32)) % 8, b = it / (8 * (SEQ / 32));
                    const int q0 = qblk * 32, qc = q0 >> 6, klo = (qc >= 8 ? qc - 8 : 0) * 64, khi = qc * 64 + 64;
                    const bf16* rowb = QKV + (size_t)b * SEQ * QKVW;
                    att::softmax_item<2, false>(rowb + (size_t)q0 * QKVW + h * 128, q0, AO + (size_t)(b * SEQ + q0) * AOW + h * 128,
                                                nullptr, nullptr, 0, 0, 0,
                                                (const char*)(rowb + TOKW + h * 128), (const char*)(rowb + 2 * TOKW + h * 128), (size_t)QKVW * 2, klo, khi, SEQ, 0,
                                                relb + h * 257, vt, lane);
                }
                for (int it = gw; it < DBAT * 8; it += NGW) {
                    const int h = it % 8, sb = it / 8;
                    const bf16* rowb = QKV + (size_t)(NP + sb * DSEQ) * QKVW;
                    const float* ck = P.in[3] + ((size_t)(j * DBAT + sb) * ACACHE) * TOKW + h * 128; const float* cv = P.in[4] + ((size_t)(j * DBAT + sb) * ACACHE) * TOKW + h * 128;
                    att::softmax_item<1, true>(rowb + h * 128, PAST, AO + (size_t)(NP + sb * DSEQ) * AOW + h * 128,
                                               (const char*)ck, (const char*)cv, (size_t)TOKW * 4, ACACHE, PAST - ACACHE,
                                               (const char*)(rowb + TOKW + h * 128), (const char*)(rowb + 2 * TOKW + h * 128), (size_t)QKVW * 2, 0, 32, DSEQ, PAST,
                                               relb + h * 257, vt, lane);
                }
            } else {
                constexpr int NIT = NB * 4 * (SEQ / 16);
                for (int r = 0; r * NGW < NIT; ++r) {
                    const int p = (r & 1) ? (r + 1) * NGW - 1 - gw : r * NGW + gw; if (p >= NIT) continue;
                    const int qi = (SEQ / 16) - 1 - p / 8, bh = p % 8, b = bh >> 2, h = bh & 3, q0 = qi * 16;
                    const bf16* rowb = QKV + (size_t)b * SEQ * QKVW;
                    att::stick_item<false>(rowb + (size_t)q0 * QKVW + h * 256, q0, AO + (size_t)(b * SEQ + q0) * AOW + h * 256,
                                           nullptr, nullptr, 0, 0,
                                           (const char*)(rowb + TOKW + h * 256), (const char*)(rowb + 2 * TOKW + h * 256), (size_t)QKVW * 2, SEQ, vt, lane);
                }
                for (int it = gw; it < DBAT * 4; it += NGW) {
                    const int h = it % 4, sb = it / 4;
                    const bf16* rowb = QKV + (size_t)(NP + sb * DSEQ) * QKVW;
                    const float* ck = P.in[5] + ((size_t)(j * DBAT + sb) * PAST) * TOKW + h * 256; const float* cv = P.in[6] + ((size_t)(j * DBAT + sb) * PAST) * TOKW + h * 256;
                    att::stick_item<true>(rowb + h * 256, 0, AO + (size_t)(NP + sb * DSEQ) * AOW + h * 256,
                                          (const char*)ck, (const char*)cv, (size_t)TOKW * 4, PAST,
                                          (const char*)(rowb + TOKW + h * 256), (const char*)(rowb + 2 * TOKW + h * 256), (size_t)QKVW * 2, DSEQ, vt, lane);
                }
            }
            for (int it = gw; it < NB * 4 * (SEQ / 32); it += NGW) {
                const int qblk = it % (SEQ / 32), h = (it / (SEQ / 32)) % 4, b = it / (4 * (SEQ / 32)), q0 = qblk * 32;
                const bf16* kb = mkv + (size_t)b * NMEM * 1024 + h * 128;
                att::softmax_item<2, false>(QKV + (size_t)(b * SEQ + q0) * QKVW + 3 * TOKW + h * 128, 0, AO + (size_t)(b * SEQ + q0) * AOW + TOKW + h * 128,
                                            nullptr, nullptr, 0, 0, 0,
                                            (const char*)kb, (const char*)(kb + MEMW), (size_t)1024 * 2, 0, NMEM, NMEM, 0, nullptr, vt, lane);
            }
            for (int it = gw; it < DBAT * 4; it += NGW) {
                const int h = it % 4, sb = it / 4;
                const float* ck = P.in[7] + ((size_t)(l * DBAT + sb) * NMEM) * MEMW + h * 128; const float* cv = P.in[8] + ((size_t)(l * DBAT + sb) * NMEM) * MEMW + h * 128;
                att::softmax_item<1, true>(QKV + (size_t)(NP + sb * DSEQ) * QKVW + 3 * TOKW + h * 128, 0, AO + (size_t)(NP + sb * DSEQ) * AOW + TOKW + h * 128,
                                           (const char*)ck, (const char*)cv, (size_t)MEMW * 4, NMEM, 0,
                                           nullptr, nullptr, 0, 0, 0, 1, 0, nullptr, vt, lane);
            }
        }
        SEAM(pb + 3);
        if (IN(pb + 4)) {
            pg8::Gemm g{AO, (const bf16*)(LW + LW_O), MR, DM, AOW}; pg8::StaticOrder S; int bx = blockIdx.x; asm volatile("" : "+s"(bx)); S.init(MR, DM, G, bx);
            EpiResid E{out, out + (size_t)NP * DM, out, XB, ssqA, TAB1};
            pg8::gemm_phase<EpiResid, pg8::StaticOrder, true, true>(lds, g, S, E);
        }
        SEAM(pb + 4);
        if (IN(pb + 5)) {
            pg8::Gemm g{XB, (const bf16*)(LW + LW_2U), MR, 2 * DFF, DM}; pg8::StaticOrder S; int bx = blockIdx.x; asm volatile("" : "+s"(bx)); S.init(MR, 2 * DFF, G, bx);
            EpiSwiGLU E{HB, ssqA};
            pg8::gemm_phase<EpiSwiGLU, pg8::StaticOrder, true, true>(lds, g, S, E);
        }
        SEAM(pb + 5);
        if (IN(pb + 6)) {
            pg8::Gemm g{HB, (const bf16*)(LW + LW_2D), MR, DM, DFF}; pg8::StaticOrder S; int bx = blockIdx.x; asm volatile("" : "+s"(bx)); S.init(MR, DM, G, bx);
            EpiResid E{out, out + (size_t)NP * DM, out, XB, ssqB, TAB1};
            pg8::gemm_phase<EpiResid, pg8::StaticOrder, true, true>(lds, g, S, E);
        }
        SEAM(pb + 6);
    }
#undef IN
#undef SEAM
}

extern "C" void kernel_launch(void* const* d_in, const int* in_sizes, int n_in, void* d_out, int out_size, void* d_ws, size_t ws_size, hipStream_t stream) {
    static int grid = 0;
    if (grid == 0) {
        if (n_in != 25 || (size_t)out_size != O_END || ws_size < WS_END) { fprintf(stderr, "kernel_launch: unexpected shapes (n_in %d out %d ws %zu)\n", n_in, out_size, ws_size); grid = -1; return; }
        int dev = 0, cus = 0, per_cu = 0;
        if (hipGetDevice(&dev) != hipSuccess || hipDeviceGetAttribute(&cus, hipDeviceAttributeMultiprocessorCount, dev) != hipSuccess) { grid = -1; return; }
        if (hipFuncSetAttribute((const void*)fwd, hipFuncAttributeMaxDynamicSharedMemorySize, LDS_BYTES) != hipSuccess) { fprintf(stderr, "kernel_launch: hipFuncSetAttribute failed\n"); grid = -1; return; }
        if (hipOccupancyMaxActiveBlocksPerMultiprocessor(&per_cu, (const void*)fwd, 512, LDS_BYTES) != hipSuccess || per_cu < 1) { fprintf(stderr, "kernel_launch: occupancy query says %d\n", per_cu); (void)hipGetLastError(); grid = -1; return; }
        grid = cus;
    }
    if (grid < 0) return;
    (void)hipMemsetAsync((char*)d_ws + WS_CTL, 0, CTL_ZERO_BYTES, stream);
    Params p; memset(&p, 0, sizeof(p));
    for (int i = 0; i < 25; ++i) p.in[i] = (const float*)d_in[i];
    p.out = (float*)d_out; p.ws = (unsigned char*)d_ws;
#if MK_MULTI
    for (int k = 0; k < NPH; ++k) { p.ph_lo = k; p.ph_hi = k + 1; hipLaunchKernelGGL(fwd, dim3(grid), dim3(512), LDS_BYTES, stream, p); }
#else
    p.ph_lo = 0; p.ph_hi = NPH; hipLaunchKernelGGL(fwd, dim3(grid), dim3(512), LDS_BYTES, stream, p);
#endif
}
```

```cpp
#include <hip/hip_runtime.h>
#include <cstdio>
#include <cstdint>
#include <cstring>
#ifndef MK_MULTI
#define MK_MULTI 0
#endif
#ifndef SB_EARLY
#define SB_EARLY 1
#endif
#ifndef DUP_P0
#define DUP_P0 0
#endif
#ifndef DUP_G1
#define DUP_G1 0
#endif
#ifndef DUP_G3
#define DUP_G3 0
#endif
#ifndef DUP_ATTA
#define DUP_ATTA 0
#endif
#ifndef DUP_ATTB
#define DUP_ATTB 0
#endif
namespace pg8 {
#define PG8_LAS __attribute__((address_space(3)))
typedef unsigned short bf16_t;
typedef short bf16x8 __attribute__((ext_vector_type(8)));
typedef float f32x4 __attribute__((ext_vector_type(4)));
typedef unsigned u32x4 __attribute__((ext_vector_type(4)));
constexpr int BM = 256, BK = 64, HALF = 128, HTB = HALF * BK * 2  , STAGE_BYTES = 8 * HTB, NXCD = 8, WGM = 8;

__host__ __device__ __forceinline__ int lds_byte(int r, int c) { const int st = (r >> 4) * 2 + (c >> 5), rr = r & 15, cc = c & 31, ob = rr * 64 + cc * 2; return st * 1024 + (ob ^ (((ob >> 9) & 1) << 5)); }
__host__ __device__ __forceinline__ void stage_rc(int b, int& R, int& C) { const int st = b / 1024, sb = b % 1024, swz = sb ^ (((sb >> 9) & 1) << 5); R = (st >> 1) * 16 + swz / 64; C = (st & 1) * 32 + (swz % 64) / 2; }
__host__ __device__ __forceinline__ int perm32(int rho) { const int n = rho >> 4, i = rho & 15; return 8 * (i >> 2) + 4 * n + (i & 3); }

struct Unit { int pm, pn; };
struct Gemm { const bf16_t* A; const bf16_t* Bt; int M, N, K; };

struct StaticOrder {
    int nM, nN, nwg, G, c;
    __host__ __device__ void init(int M, int N, int G_, int c_) { nM = M / BM; nN = N / BM; nwg = nM * nN; G = G_; c = c_; }
    __host__ __device__ bool next(int i, Unit& u) const {
        const long L = (long)i * G + c; if (L >= nwg) return false;
        int wgid = (int)L; { const int q = nwg / NXCD, r = nwg % NXCD, xcd = wgid % NXCD, off = wgid / NXCD; wgid = (xcd < r ? xcd * (q + 1) : r * (q + 1) + (xcd - r) * q) + off; }
        const int nig = WGM * nN, gid = wgid / nig, fm = gid * WGM, gsz = (nM - fm) < WGM ? (nM - fm) : WGM;
        u.pm = fm + ((wgid % nig) % gsz); u.pn = (wgid % nig) / gsz; return true;
    }
    __device__ __forceinline__ void a_ready(const Unit&) const {}
    __device__ __forceinline__ void done(const Unit&) const {}
};

__device__ __forceinline__ unsigned cvt_pk_bf16(float lo, float hi) { unsigned r; asm volatile("v_cvt_pk_bf16_f32 %0, %1, %2" : "=v"(r) : "v"(lo), "v"(hi)); return r; }
typedef float f32x2 __attribute__((ext_vector_type(2)));
template <class Epi, class Sched, bool ALIGN_EPI = false, bool SP2 = false>
__device__ __forceinline__ void gemm_phase(PG8_LAS unsigned char* lds, const Gemm g, const Sched& S, const Epi& E) {
    int tid_ = threadIdx.x; asm volatile("" : "+v"(tid_));
    const int tid = tid_, wid = __builtin_amdgcn_readfirstlane(tid >> 6), lane = tid & 63, wr = wid >> 2, wc = wid & 3, fr = lane & 15, fq = lane >> 4;
    const int K = g.K, nt = K / BK;
    unsigned voffA[2], voffB[2];
#pragma unroll
    for (int i = 0; i < 2; ++i) { int R, C; stage_rc(tid * 16 + i * 8192, R, C); const int Rb = Epi::PERM ? ((R & ~31) + perm32(R & 31)) : R;
        voffA[i] = (unsigned)(R * K + C) * 2u; voffB[i] = (unsigned)(Rb * K + C) * 2u; }
    const size_t kstep = (size_t)(BK * 2);
    const size_t hstep = (size_t)HALF * K * 2;
    const size_t tstep = 2 * hstep;
    const unsigned ldsw = (unsigned)wid * 1024u;
    const int aoff = lds_byte(wr * 64 + fr, fq * 8), boff = lds_byte(wc * 32 + fr, fq * 8);
#define PG8_SA(b, h) (((b) * 2 + (h)) * HTB)
#define PG8_SB(b, h) ((4 + (b) * 2 + (h)) * HTB)
#define PG8_STAGE(bufoff, gbase, voff) do { _Pragma("unroll") for (int _i = 0; _i < 2; ++_i) \
        __builtin_amdgcn_global_load_lds((const unsigned*)((const char*)(gbase) + (voff)[_i]), (PG8_LAS unsigned*)(lds + (bufoff) + ldsw + _i * 8192), 16, 0, 0); } while (0)
#define PG8_LDA(dst, b, h) do { _Pragma("unroll") for (int m = 0; m < 4; ++m) _Pragma("unroll") for (int k = 0; k < 2; ++k) dst[m][k] = *(const PG8_LAS bf16x8*)(lds + PG8_SA(b, h) + aoff + m * 2048 + k * 1024); } while (0)
#define PG8_LDB(dst, b, h) do { _Pragma("unroll") for (int n = 0; n < 2; ++n) _Pragma("unroll") for (int k = 0; k < 2; ++k) dst[n][k] = *(const PG8_LAS bf16x8*)(lds + PG8_SB(b, h) + boff + n * 2048 + k * 1024); } while (0)
#define PG8_MMA(ai, bj, At, Bt) do { __builtin_amdgcn_s_setprio(1); _Pragma("unroll") for (int m = 0; m < 4; ++m) _Pragma("unroll") for (int n = 0; n < 2; ++n) _Pragma("unroll") for (int k = 0; k < 2; ++k) \
        acc[ai][bj][m][n] = __builtin_amdgcn_mfma_f32_16x16x32_bf16(Bt[n][k], At[m][k], acc[ai][bj][m][n], 0, 0, 0); __builtin_amdgcn_s_setprio(0); } while (0)
#define PG8_WAIT_V(n) asm volatile("s_waitcnt vmcnt(" #n ")" ::: "memory")
#define PG8_WAIT_L(n) asm volatile("s_waitcnt lgkmcnt(" #n ")" ::: "memory")
#define PG8_BAR __builtin_amdgcn_s_barrier()
#define PG8_SCHED __builtin_amdgcn_sched_barrier(0)
    Unit cur, nxt; int ui = 0;
    if (!S.next(0, cur)) return;
    f32x4 acc[2][2][4][2];
#pragma unroll
    for (int a = 0; a < 2; ++a)
#pragma unroll
        for (int b = 0; b < 2; ++b)
#pragma unroll
            for (int m = 0; m < 4; ++m)
#pragma unroll
                for (int n = 0; n < 2; ++n) acc[a][b][m][n] = (f32x4){0.f, 0.f, 0.f, 0.f};
    bf16x8 At[4][2], B0[2][2], B1[2][2];
    const char* cA = (const char*)g.A + (size_t)cur.pm * tstep; const char* cB = (const char*)g.Bt + (size_t)cur.pn * tstep;
    S.a_ready(cur);
    if constexpr (SP2) {
        PG8_STAGE(PG8_SB(0, 0), cB, voffB); PG8_STAGE(PG8_SB(0, 1), cB + hstep, voffB); PG8_STAGE(PG8_SA(0, 0), cA, voffA); PG8_STAGE(PG8_SA(0, 1), cA + hstep, voffA);
        if (wr == 1) PG8_BAR;
        PG8_WAIT_V(2); PG8_BAR;
        PG8_STAGE(PG8_SB(1, 0), cB + kstep, voffB); PG8_STAGE(PG8_SA(1, 0), cA + kstep, voffA); PG8_STAGE(PG8_SB(1, 1), cB + hstep + kstep, voffB);
        PG8_WAIT_V(6); PG8_BAR;
    } else {
        PG8_STAGE(PG8_SB(0, 0), cB, voffB); PG8_STAGE(PG8_SA(0, 0), cA, voffA); PG8_STAGE(PG8_SB(0, 1), cB + hstep, voffB); PG8_STAGE(PG8_SA(0, 1), cA + hstep, voffA);
        if (wr == 1) PG8_BAR;
        PG8_WAIT_V(4); PG8_BAR;
        PG8_STAGE(PG8_SB(1, 0), cB + kstep, voffB); PG8_STAGE(PG8_SA(1, 0), cA + kstep, voffA); PG8_STAGE(PG8_SB(1, 1), cB + hstep + kstep, voffB);
        PG8_WAIT_V(6); PG8_BAR;
    }
    for (;;) {
        const bool has_next = S.next(ui + 1, nxt);
        const char* nA = has_next ? (const char*)g.A + (size_t)nxt.pm * tstep : cA; const char* nB = has_next ? (const char*)g.Bt + (size_t)nxt.pn * tstep : cB;
        for (int t = 0; t < nt; t += 2) {
            const bool last = (t == nt - 2);
            const char* a1 = cA + (size_t)(t + 1) * kstep;
            const char* a2 = last ? nA : cA + (size_t)(t + 2) * kstep; const char* b2 = last ? nB : cB + (size_t)(t + 2) * kstep;
            const char* a3 = a2 + kstep; const char* b3 = b2 + kstep;
            if (last && has_next) S.a_ready(nxt);
            if constexpr (SP2) {
            PG8_LDB(B0, 0, 0); PG8_LDB(B1, 0, 1); PG8_SCHED; PG8_LDA(At, 0, 0); PG8_STAGE(PG8_SA(1, 1), a1 + hstep, voffA);
            PG8_WAIT_V(8); PG8_WAIT_L(0); PG8_BAR; PG8_MMA(0, 0, At, B0); PG8_MMA(0, 1, At, B1); PG8_BAR; PG8_SCHED;
            PG8_LDA(At, 0, 1); PG8_STAGE(PG8_SB(0, 0), b2, voffB); PG8_STAGE(PG8_SB(0, 1), b2 + hstep, voffB); PG8_STAGE(PG8_SA(0, 0), a2, voffA);
            PG8_WAIT_V(8); PG8_WAIT_L(0); PG8_BAR; PG8_MMA(1, 0, At, B0); PG8_MMA(1, 1, At, B1); PG8_BAR; PG8_SCHED;
            PG8_LDB(B0, 1, 0); PG8_LDB(B1, 1, 1); PG8_SCHED; PG8_LDA(At, 1, 0); PG8_STAGE(PG8_SA(0, 1), a2 + hstep, voffA);
            PG8_WAIT_V(8); PG8_WAIT_L(0); PG8_BAR; PG8_MMA(0, 0, At, B0); PG8_MMA(0, 1, At, B1); PG8_BAR; PG8_SCHED;
            PG8_LDA(At, 1, 1); PG8_STAGE(PG8_SB(1, 0), b3, voffB); PG8_STAGE(PG8_SB(1, 1), b3 + hstep, voffB); PG8_STAGE(PG8_SA(1, 0), a3, voffA);
            PG8_WAIT_V(8); PG8_WAIT_L(0); PG8_BAR; PG8_MMA(1, 0, At, B0); PG8_MMA(1, 1, At, B1); PG8_BAR; PG8_SCHED;
            } else {
            PG8_LDB(B0, 0, 0); PG8_SCHED; PG8_LDA(At, 0, 0); PG8_STAGE(PG8_SA(1, 1), a1 + hstep, voffA);
            PG8_WAIT_L(8); PG8_BAR; PG8_WAIT_L(0); PG8_MMA(0, 0, At, B0); PG8_BAR; PG8_SCHED;
            PG8_LDB(B1, 0, 1); PG8_STAGE(PG8_SB(0, 0), b2, voffB);
            PG8_BAR; PG8_WAIT_L(0); PG8_MMA(0, 1, At, B1); PG8_BAR;
            PG8_LDA(At, 0, 1); PG8_STAGE(PG8_SA(0, 0), a2, voffA);
            PG8_BAR; PG8_WAIT_L(0); PG8_MMA(1, 0, At, B0); PG8_BAR; PG8_SCHED;
            PG8_STAGE(PG8_SB(0, 1), b2 + hstep, voffB);
            PG8_WAIT_V(6); PG8_BAR; PG8_MMA(1, 1, At, B1); PG8_BAR;
            PG8_LDB(B0, 1, 0); PG8_SCHED; PG8_LDA(At, 1, 0); PG8_STAGE(PG8_SA(0, 1), a2 + hstep, voffA);
            PG8_WAIT_L(8); PG8_BAR; PG8_WAIT_L(0); PG8_MMA(0, 0, At, B0); PG8_BAR; PG8_SCHED;
            PG8_LDB(B1, 1, 1); PG8_STAGE(PG8_SB(1, 0), b3, voffB);
            PG8_BAR; PG8_WAIT_L(0); PG8_MMA(0, 1, At, B1); PG8_BAR;
            PG8_LDA(At, 1, 1); PG8_STAGE(PG8_SA(1, 0), a3, voffA);
            PG8_BAR; PG8_WAIT_L(0); PG8_MMA(1, 0, At, B0); PG8_BAR; PG8_SCHED;
            PG8_STAGE(PG8_SB(1, 1), b3 + hstep, voffB);
            PG8_WAIT_V(6); PG8_BAR; PG8_MMA(1, 1, At, B1); PG8_BAR;
            }
        }
        if constexpr (ALIGN_EPI) { if (wr == 0) PG8_BAR; }
        if constexpr (!Epi::AFTER_DRAIN) { E(acc, cur, wr, wc, fr, fq); S.done(cur); }
        if (!has_next) break;
#pragma unroll
        for (int a = 0; a < 2; ++a)
#pragma unroll
            for (int b = 0; b < 2; ++b)
#pragma unroll
                for (int m = 0; m < 4; ++m)
#pragma unroll
                    for (int n = 0; n < 2; ++n) acc[a][b][m][n] = (f32x4){0.f, 0.f, 0.f, 0.f};
        cur = nxt; cA = nA; cB = nB; ++ui;
        if constexpr (ALIGN_EPI) { if (wr == 1) PG8_BAR; }
    }
    PG8_WAIT_V(0);
    if constexpr (!ALIGN_EPI) { if (wr == 0) PG8_BAR; }
    PG8_BAR;
    if constexpr (Epi::AFTER_DRAIN) { E.fused(acc, cur, wr, wc, fr, fq, lds, wid, lane); S.done(cur); }
#undef PG8_SA
#undef PG8_SB
#undef PG8_STAGE
#undef PG8_LDA
#undef PG8_LDB
#undef PG8_MMA
#undef PG8_WAIT_V
#undef PG8_WAIT_L
#undef PG8_BAR
#undef PG8_SCHED
}
}


#define GAS __attribute__((address_space(1)))
#define LAS __attribute__((address_space(3)))
typedef unsigned short bf16;
typedef float f32x4 __attribute__((ext_vector_type(4)));
typedef short bf16x8 __attribute__((ext_vector_type(8)));
typedef short s16x4 __attribute__((ext_vector_type(4)));
typedef unsigned u32x4 __attribute__((ext_vector_type(4)));
typedef unsigned u32x2 __attribute__((ext_vector_type(2)));
constexpr int DM = 2048, DFF = 3072, SEQ = 16384, NB = 2, NP = NB * SEQ, DBAT = 32, DSEQ = 16, NS = DBAT * DSEQ, MR = NP + NS;
constexpr int NMEM = 256, NMR = NB * NMEM, MRX = MR + NMR;
constexpr int QKVW = 3584, AOW = 1536, INW = 4608, TOKW = 1024, MEMW = 512;
constexpr int PAST = 1024, ACACHE = 512, NLAYER = 4;
constexpr float EPS = 1e-6f;
constexpr int NPH = 1 + 7 * NLAYER;
constexpr size_t O_Y = 0, O_AKP = (size_t)MR * DM, O_AVP = O_AKP + 2097152, O_BKP = O_AVP + 2097152, O_BVP = O_BKP + 67108864, O_MKP = O_BVP + 67108864,
                 O_MVP = O_MKP + 1048576, O_AKS = O_MVP + 1048576, O_AVS = O_AKS + 1048576, O_BKS = O_AVS + 1048576, O_BVS = O_BKS + 1048576, O_END = O_BVS + 1048576;
static_assert(O_END == 212860928, "output size");
constexpr size_t MiB = 1u << 20;
constexpr size_t WS_CTL = 0, CTL_ZERO_BYTES = 1 * MiB;
constexpr size_t LW_1U = 0, LW_1D = LW_1U + (size_t)2 * DFF * DM * 2, LW_IN = LW_1D + (size_t)DM * DFF * 2, LW_O = LW_IN + (size_t)INW * DM * 2, LW_2U = LW_O + (size_t)DM * AOW * 2,
                 LW_2D = LW_2U + (size_t)2 * DFF * DM * 2, LW_SIZE = LW_2D + (size_t)DM * DFF * 2;
static_assert(LW_SIZE == 96 * MiB, "per-layer weight bytes");
constexpr size_t WS_W = 1 * MiB, WS_XB = WS_W + NLAYER * LW_SIZE, WS_H = WS_XB + 132 * MiB, WS_QKV = WS_H + 195 * MiB, WS_AO = WS_QKV + 228 * MiB, WS_MKV = WS_AO + 98 * MiB,
                 WS_SSQ = WS_MKV + 4 * MiB, WS_DBG = WS_SSQ + 3 * MiB, WS_END = WS_DBG + 1 * MiB;
static_assert((size_t)MRX * DM * 2 <= 132 * MiB && (size_t)MR * DFF * 2 <= 195 * MiB && (size_t)MR * QKVW * 2 <= 228 * MiB && (size_t)MR * AOW * 2 <= 98 * MiB, "ws map");
constexpr size_t SSQ_BUF = (size_t)MR * 8;
constexpr int RING_BYTES = 131072, TAB1_OFF = 131072  , TAB2_OFF = 135168  , MISC_OFF = 143360, LDS_BYTES = 147456;
constexpr int VT_STRIDE = 17408;
static_assert(8 * VT_STRIDE <= MISC_OFF, "lds map");

#define RLX_AGENT __ATOMIC_RELAXED, __HIP_MEMORY_SCOPE_AGENT
#define LDS_WAIT() asm volatile("s_waitcnt lgkmcnt(0)" ::: "memory")
#define VM_WAIT() asm volatile("s_waitcnt vmcnt(0)" ::: "memory")
__device__ __forceinline__ unsigned pkbf(float lo, float hi) { typedef float f2 __attribute__((ext_vector_type(2))); typedef __bf16 b2 __attribute__((ext_vector_type(2))); f2 v = {lo, hi}; b2 b = __builtin_convertvector(v, b2); return __builtin_bit_cast(unsigned, b); }
__device__ __forceinline__ float fexp(float x) { return __builtin_amdgcn_exp2f(x * 1.4426950408889634f); }
__device__ __forceinline__ float flog(float x) { return __builtin_amdgcn_logf(x) * 0.6931471805599453f; }
__device__ __forceinline__ float dot4(f32x4 a) { return (a.x * a.x + a.y * a.y) + (a.z * a.z + a.w * a.w); }
__device__ __forceinline__ float row_rscale(const float* ssq, int row) {
    const f32x4 a = *(const f32x4*)(ssq + (size_t)row * 8), b = *(const f32x4*)(ssq + (size_t)row * 8 + 4);
    return __builtin_amdgcn_rsqf(((a.x + a.y) + (a.z + a.w) + (b.x + b.y) + (b.z + b.w)) * (1.0f / DM) + EPS);
}
#define EPI_BAR() do { asm volatile("s_waitcnt lgkmcnt(0)" ::: "memory"); __builtin_amdgcn_s_barrier(); asm volatile("" ::: "memory"); } while (0)

typedef pg8::f32x4 acc_t[2][2][4][2];

struct EpiSwiGLU {
    static constexpr bool PERM = true, AFTER_DRAIN = false;
    bf16* H; const float* ssq;
    __device__ __forceinline__ void operator()(const acc_t& acc, const pg8::Unit& u, int wr, int wc, int fr, int fq) const {
        const int row0 = u.pm * 256 + wr * 64 + fr, col0 = u.pn * 128 + wc * 32 + 8 * fq;
#pragma unroll
        for (int ai = 0; ai < 2; ++ai)
#pragma unroll
            for (int m = 0; m < 4; ++m) {
                const int row = row0 + ai * 128 + m * 16; const float r = row_rscale(ssq, row);
                float hv[8];
#pragma unroll
                for (int n = 0; n < 2; ++n)
#pragma unroll
                    for (int e = 0; e < 4; ++e) { const float a = acc[ai][0][m][n][e] * r, b = acc[ai][1][m][n][e] * r;
                        hv[n * 4 + e] = a * __builtin_amdgcn_rcpf(1.0f + fexp(-a)) * b; }
                u32x4 w; w.x = pkbf(hv[0], hv[1]); w.y = pkbf(hv[2], hv[3]); w.z = pkbf(hv[4], hv[5]); w.w = pkbf(hv[6], hv[7]);
                *(u32x4*)(H + (size_t)row * DFF + col0) = w;
            }
    }
};

struct EpiResid {
    static constexpr bool PERM = true, AFTER_DRAIN = false;
    const float* base_p; const float* base_s;
    float* out; bf16* xb; float* ssq_out; LAS float* tab;
    __device__ __forceinline__ void operator()(const acc_t& acc, const pg8::Unit& u, int wr, int wc, int fr, int fq) const {
        const int rl0 = wr * 64 + fr, row0 = u.pm * 256 + rl0, col0 = u.pn * 256 + wc * 32 + 8 * fq;
        const float* base = (u.pm < NP / 256) ? base_p : (base_s - (size_t)NP * DM);
#pragma unroll
        for (int ai = 0; ai < 2; ++ai)
#pragma unroll
            for (int m = 0; m < 4; ++m) {
                const int row = row0 + ai * 128 + m * 16; float sq = 0.f;
#pragma unroll
                for (int bj = 0; bj < 2; ++bj) {
                    const size_t o = (size_t)row * DM + col0 + bj * 128;
                    const f32x4 x0 = *(const f32x4*)(base + o), x1 = *(const f32x4*)(base + o + 4);
                    const f32x4 v0 = x0 + acc[ai][bj][m][0], v1 = x1 + acc[ai][bj][m][1];
                    *(f32x4*)(out + o) = v0; *(f32x4*)(out + o + 4) = v1;
                    u32x4 w; w.x = pkbf(v0.x, v0.y); w.y = pkbf(v0.z, v0.w); w.z = pkbf(v1.x, v1.y); w.w = pkbf(v1.z, v1.w);
                    *(u32x4*)(xb + o) = w;
                    sq += dot4(v0) + dot4(v1);
                }
                sq += __shfl_xor(sq, 16); sq += __shfl_xor(sq, 32);
                if (fq == 0) tab[(rl0 + ai * 128 + m * 16) * 4 + wc] = sq;
            }
        EPI_BAR();
#pragma unroll
        for (int t = 0; t < 2; ++t) { const int g = wc * 2 + t, rl = (g >> 2) * 128 + (g & 3) * 16 + rl0;
            if (fq == 0) { const f32x4 p = *(const LAS f32x4*)(tab + rl * 4); ssq_out[(size_t)(u.pm * 256 + rl) * 8 + u.pn] = (p.x + p.y) + (p.z + p.w); } }
    }
};

struct EpiQKV {
    static constexpr bool PERM = true, AFTER_DRAIN = false;
    bf16* QKV; bf16* MKV; const float* ssq; const float* gains;
    float* out; int l;
    LAS float* tab2;
    __device__ __forceinline__ void operator()(const acc_t& acc, const pg8::Unit& u, int wr, int wc, int fr, int fq) const {
        const int pm = u.pm, pn = u.pn; const bool memrow = pm >= MR / 256; const int layerB = l & 1, j = l >> 1;
        const int rl0 = wr * 64 + fr, row0 = pm * 256 + rl0, cw = wc * 32 + 8 * fq;
        const int kind = memrow ? (pn < 16 ? 4 : 5) : (pn < 4 ? 0 : pn < 8 ? 1 : pn < 12 ? 2 : 3);
        const bool need_norm = (kind == 3) || (kind == 4) || (!layerB && kind <= 1);
        acc_t& va = const_cast<acc_t&>(acc);
#define VQ(ai, bj, m, e) va[ai][bj][m][(e) >> 2][(e) & 3]
        int zo = 0;
#pragma unroll
        for (int ai = 0; ai < 2; ++ai)
#pragma unroll
            for (int m = 0; m < 4; ++m) {
                asm volatile("" : "+s"(zo) :: "memory");
                const int rl = rl0 + ai * 128 + m * 16 + zo;
                const float r = memrow ? 1.0f : row_rscale(ssq, pm * 256 + rl);
#pragma unroll
                for (int bj = 0; bj < 2; ++bj) {
#pragma unroll
                    for (int n = 0; n < 2; ++n) va[ai][bj][m][n] *= r;
                    if (need_norm) { float sq = dot4(va[ai][bj][m][0]) + dot4(va[ai][bj][m][1]);
                        sq += __shfl_xor(sq, 16); sq += __shfl_xor(sq, 32);
                        if (fq == 0) tab2[(rl * 2 + bj) * 4 + wc] = sq; }
                }
            }
        float g[8];
        if (need_norm) {
            EPI_BAR();
            const float* gp = gains + ((kind == 0) ? 0 : (kind == 1) ? 128 : (kind == 3) ? 256 : 384);
            const float post = (kind == 0 || kind == 3) ? 0.08838834764831845f : 1.0f;
#pragma unroll
            for (int e = 0; e < 8; ++e) g[e] = gp[cw + e] * post;
        } else {
            const float post = (kind == 0) ? 0.0625f : 1.0f;
#pragma unroll
            for (int e = 0; e < 8; ++e) g[e] = post;
        }
        float* fo = nullptr; int fpitch = TOKW;
        const int ct = (kind == 1) ? (pn - 4) * 256 : (kind == 2) ? (pn - 8) * 256 : (kind == 4) ? (pn - 14) * 256 : (kind == 5) ? (pn - 16) * 256 : 0;
        if (kind == 1 || kind == 2) {
            const bool isk = kind == 1;
            if (pm >= NP / 256) fo = out + (layerB ? (isk ? O_BKS : O_BVS) : (isk ? O_AKS : O_AVS)) + (size_t)j * NS * TOKW + (size_t)(pm * 256 - NP) * TOKW;
            else if (layerB) fo = out + (isk ? O_BKP : O_BVP) + (size_t)j * NP * TOKW + (size_t)(pm * 256) * TOKW;
            else if ((pm & 63) >= 62) fo = out + (isk ? O_AKP : O_AVP) + (size_t)j * NB * 512 * TOKW + (size_t)((pm >> 6) * 512 + ((pm & 63) - 62) * 256) * TOKW;
        } else if (kind >= 4) { fo = out + (kind == 4 ? O_MKP : O_MVP) + (size_t)l * NMR * MEMW + (size_t)(pm * 256 - MR) * MEMW; fpitch = MEMW; }
        if (fo) fo += ct + cw;
        bf16* bo = memrow ? MKV + (size_t)(pm * 256 - MR) * 1024 + (pn - 14) * 256 + cw : QKV + (size_t)(pm * 256) * QKVW + pn * 256 + cw;
        const int bpitch = memrow ? 1024 : QKVW;
#pragma unroll
        for (int ai = 0; ai < 2; ++ai)
#pragma unroll
            for (int m = 0; m < 4; ++m) {
                asm volatile("" : "+s"(zo) :: "memory");
                const int rl = rl0 + ai * 128 + m * 16 + zo;
#pragma unroll
                for (int bj = 0; bj < 2; ++bj) {
                    float rn = 1.0f;
                    if (need_norm) { const f32x4 p = *(const LAS f32x4*)(tab2 + (rl * 2 + bj) * 4); rn = __builtin_amdgcn_rsqf(((p.x + p.y) + (p.z + p.w)) * (1.0f / 128.0f) + EPS); }
#pragma unroll
                    for (int e = 0; e < 8; ++e) VQ(ai, bj, m, e) *= rn * g[e];
                    const f32x4 x0 = va[ai][bj][m][0], x1 = va[ai][bj][m][1];
                    u32x4 w; w.x = pkbf(x0.x, x0.y); w.y = pkbf(x0.z, x0.w); w.z = pkbf(x1.x, x1.y); w.w = pkbf(x1.z, x1.w);
                    *(u32x4*)(bo + (size_t)rl * bpitch + bj * 128) = w;
                    if (fo) { float* p = fo + (size_t)rl * fpitch + bj * 128; *(f32x4*)p = x0; *(f32x4*)(p + 4) = x1; }
                }
            }
    }
};
#undef VQ
struct G3Order {
    pg8::StaticOrder so; int G, c;
    __device__ void init(int G_, int c_) { so.init(MR, QKVW, G_, c_); G = G_; c = c_; }
    __device__ bool next(int i, pg8::Unit& u) const {
        const long L = (long)i * G + c;
        if (L < so.nwg) return so.next(i, u);
        const int j = (int)(L - so.nwg); if (j >= 8) return false;
        u.pm = MR / 256 + (j >> 2); u.pn = 14 + (j & 3); return true;
    }
    __device__ __forceinline__ void a_ready(const pg8::Unit&) const {}
    __device__ __forceinline__ void done(const pg8::Unit&) const {}
};
#define XB_TMO      128
#define XB_XCNT(j)  (256  + 64 * (j))
#define XB_XSUB(j)  (1280 + 64 * (j))
#define XB_XGEN(j)  (2304 + 64 * (j))
#define XB_TOP      3328
#define XB_TOPGEN   3392
#define XCD_BAR_WORDS 3456
#define XB_SPIN_CAP (1u << 18)

__device__ __forceinline__ unsigned xb_ld(unsigned* p)              { return __hip_atomic_load(p, __ATOMIC_RELAXED, __HIP_MEMORY_SCOPE_AGENT); }
__device__ __forceinline__ unsigned xb_add(unsigned* p, unsigned v) { return __hip_atomic_fetch_add(p, v, __ATOMIC_RELAXED, __HIP_MEMORY_SCOPE_AGENT); }
__device__ __forceinline__ unsigned xb_xcc_id() { return (unsigned)__builtin_amdgcn_s_getreg((3 << 11) | 20) & 0xFu; }
#define XB_SPIN(cond, bar) do { unsigned _sp = 0; while (cond) { __builtin_amdgcn_s_sleep(1); \
    if ((++_sp & 255u) == 0u) { if (xb_ld(&(bar)[XB_TMO])) break; if (_sp > XB_SPIN_CAP) { atomicAdd(&(bar)[XB_TMO], 1u); break; } } } } while (0)

struct XcdBarrier {
    unsigned* bar; unsigned x;
    volatile LAS unsigned* st;
};

__device__ __forceinline__ XcdBarrier xcd_barrier_post(unsigned* bar, volatile LAS unsigned* st) {
    XcdBarrier b; b.bar = bar; b.x = xb_xcc_id(); b.st = st;
    if (threadIdx.x == 0) (void)xb_add(&bar[XB_XCNT(b.x)], 1u);
    return b;
}
__device__ __forceinline__ void xcd_barrier_complete(unsigned* bar, unsigned x, unsigned& nloc, unsigned& nx) {
    const unsigned G = gridDim.x * gridDim.y * gridDim.z;
    unsigned sum, cnt, mine, sp = 0u;
    for (;;) {
        sum = 0u; cnt = 0u; mine = 0u;
#pragma unroll
        for (unsigned j = 0; j < 16; ++j) { const unsigned c = xb_ld(&bar[XB_XCNT(j)]); sum += c; cnt += (c > 0u) ? 1u : 0u; mine = (j == x) ? c : mine; }
        if (sum == G) break;
        __builtin_amdgcn_s_sleep(1);
        if ((++sp & 255u) == 0u) { if (xb_ld(&bar[XB_TMO])) break; if (sp > XB_SPIN_CAP) { atomicAdd(&bar[XB_TMO], 1u); break; } }
    }
    nloc = mine > 0u ? mine : 1u; nx = cnt > 0u ? cnt : 1u;
}

__device__ __forceinline__ void xcd_barrier(const XcdBarrier& b) {
    asm volatile("s_waitcnt vmcnt(0)" ::: "memory");
    __syncthreads();
    if (threadIdx.x == 0) {
        unsigned* bar = b.bar;
        __builtin_amdgcn_s_waitcnt(0);
        unsigned nloc = b.st[0], nx = b.st[1];
        if (nloc == 0u) { xcd_barrier_complete(bar, b.x, nloc, nx); b.st[0] = nloc; b.st[1] = nx; }
        const unsigned old = xb_add(&bar[XB_XSUB(b.x)], 1u);
        const unsigned gen = old / nloc;
        if (old + 1u == (gen + 1u) * nloc) {
            __builtin_amdgcn_fence(__ATOMIC_RELEASE, "agent");
            asm volatile("s_waitcnt vmcnt(0)" ::: "memory");
            const unsigned og = xb_add(&bar[XB_TOP], 1u);
            const unsigned tg = og / nx;
            if (og + 1u == (tg + 1u) * nx) xb_add(&bar[XB_TOPGEN], 1u);
            else XB_SPIN(xb_ld(&bar[XB_TOPGEN]) == tg, bar);
            __builtin_amdgcn_fence(__ATOMIC_ACQUIRE, "agent");
            xb_add(&bar[XB_XGEN(b.x)], 1u);
            asm volatile("s_waitcnt vmcnt(0)" ::: "memory");
        } else {
            XB_SPIN(xb_ld(&bar[XB_XGEN(b.x)]) == gen, bar);
            __builtin_amdgcn_fence(__ATOMIC_ACQUIRE, "agent");
            asm volatile("s_waitcnt vmcnt(0)" ::: "memory");
        }
    }
    __syncthreads();
}


namespace att {
#define MFMA16(a, b, c) __builtin_amdgcn_mfma_f32_16x16x32_bf16((a), (b), (c), 0, 0, 0)
typedef short v4i16_t __attribute__((ext_vector_type(4)));
__device__ __forceinline__ s16x4 vtr(const LAS char* p) { return __builtin_bit_cast(s16x4, __builtin_amdgcn_ds_read_tr16_b64_v4i16((LAS v4i16_t*)p)); }

template <bool F32> __device__ __forceinline__ bf16x8 ld8(const char* rowp, int col) {
    if constexpr (F32) { const f32x4 a = *(const f32x4*)(rowp + (size_t)col * 4), b = *(const f32x4*)(rowp + (size_t)col * 4 + 16);
        u32x4 w; w.x = pkbf(a.x, a.y); w.y = pkbf(a.z, a.w); w.z = pkbf(b.x, b.y); w.w = pkbf(b.z, b.w); return __builtin_bit_cast(bf16x8, w); }
    else return *(const bf16x8*)(rowp + (size_t)col * 2);
}
template <int HD, int QB> __device__ __forceinline__ void load_q(bf16x8 (&qf)[QB][HD / 32], const bf16* q  , int fr, int fq) {
#pragma unroll
    for (int qb = 0; qb < QB; ++qb)
#pragma unroll
        for (int ks = 0; ks < HD / 32; ++ks) qf[qb][ks] = *(const bf16x8*)(q + (size_t)(16 * qb + fr) * QKVW + 32 * ks + 8 * fq);
}
template <int HD, int QB, bool F32> __device__ __forceinline__ void qk_tile(f32x4 (&s)[2][QB], const bf16x8 (&qf)[QB][HD / 32], const char* kbase, size_t pitchB, int key0, int kmax, int fr, int fq) {
#pragma unroll
    for (int u = 0; u < 2; ++u) {
        int row = key0 + 16 * u + fr; row = row < kmax ? row : kmax;
        const char* rp = kbase + (size_t)row * pitchB;
        bf16x8 kf[HD / 32];
#pragma unroll
        for (int ks = 0; ks < HD / 32; ++ks) kf[ks] = ld8<F32>(rp, 32 * ks + 8 * fq);
#pragma unroll
        for (int qb = 0; qb < QB; ++qb) { f32x4 a = {0.f, 0.f, 0.f, 0.f};
#pragma unroll
            for (int ks = 0; ks < HD / 32; ++ks) a = MFMA16(kf[ks], qf[qb][ks], a);
            s[u][qb] = a; }
    }
}
template <int HD, bool F32> __device__ __forceinline__ void stage_v(LAS char* vt, const char* vbase, size_t pitchB, int key0, int kmax, int lane) {
    constexpr int CPR = HD / 8, PITCH = HD * 2 + 32;
#pragma unroll
    for (int i = 0; i < 32 * CPR / 64; ++i) { const int n = lane + 64 * i, row = n / CPR, ch = n % CPR; int grow = key0 + row; grow = grow < kmax ? grow : kmax;
        const bf16x8 v = ld8<F32>(vbase + (size_t)grow * pitchB, ch * 8);
        *(LAS bf16x8*)(vt + row * PITCH + ch * 16) = v; }
}
template <int HD, int QB, int PITCH = HD * 2 + 32> __device__ __forceinline__ void pv_tile(f32x4 (&o)[HD / 16][QB], const bf16x8 (&pf)[QB], const LAS char* vt, int lane) {
    const int fq = lane >> 4, q = (lane & 15) >> 2, p = lane & 3;
    const LAS char* base = vt + (4 * fq + q) * PITCH + p * 8;
#pragma unroll
    for (int c = 0; c < HD / 16; ++c) {
        const s16x4 lo = vtr(base + c * 32), hi = vtr(base + 16 * PITCH + c * 32);
        const bf16x8 vf = __builtin_shufflevector(lo, hi, 0, 1, 2, 3, 4, 5, 6, 7);
#pragma unroll
        for (int qb = 0; qb < QB; ++qb) o[c][qb] = MFMA16(vf, pf[qb], o[c][qb]);
    }
}
__device__ __forceinline__ bf16x8 pack8(const f32x4& a, const f32x4& b) { u32x4 w; w.x = pkbf(a.x, a.y); w.y = pkbf(a.z, a.w); w.z = pkbf(b.x, b.y); w.w = pkbf(b.z, b.w); return __builtin_bit_cast(bf16x8, w); }

template <int HD, int QB> __device__ __forceinline__ void softmax_step(f32x4 (&s)[2][QB], const unsigned (&vmask)[QB], float (&m)[QB], float (&l)[QB], f32x4 (&o)[HD / 16][QB], bf16x8 (&pf)[QB]) {
#pragma unroll
    for (int qb = 0; qb < QB; ++qb) {
        float mx = -1e30f;
#pragma unroll
        for (int u = 0; u < 2; ++u)
#pragma unroll
            for (int i = 0; i < 4; ++i) { const bool ok = (vmask[qb] >> (4 * u + i)) & 1u; s[u][qb][i] = ok ? s[u][qb][i] : -1e30f; mx = fmaxf(mx, s[u][qb][i]); }
        mx = fmaxf(mx, __shfl_xor(mx, 16)); mx = fmaxf(mx, __shfl_xor(mx, 32));
        const float mn = fmaxf(m[qb], mx), alpha = fexp(m[qb] - mn);
        float ps = 0.f;
#pragma unroll
        for (int u = 0; u < 2; ++u)
#pragma unroll
            for (int i = 0; i < 4; ++i) { const bool ok = (vmask[qb] >> (4 * u + i)) & 1u; const float p = ok ? fexp(s[u][qb][i] - mn) : 0.f; s[u][qb][i] = p; ps += p; }
        l[qb] = l[qb] * alpha + ps; m[qb] = mn;
#pragma unroll
        for (int c = 0; c < HD / 16; ++c) o[c][qb] *= alpha;
        pf[qb] = pack8(s[0][qb], s[1][qb]);
    }
}
__device__ __forceinline__ void stick_step(f32x4 (&s)[2][1], unsigned vmask, float& R, bf16x8& pf, int fq) {
    float sp[2][4], suf[2][4], tot[2], later[2];
#pragma unroll
    for (int u = 0; u < 2; ++u) {
#pragma unroll
        for (int i = 0; i < 4; ++i) { const bool ok = (vmask >> (4 * u + i)) & 1u; const float z = s[u][0][i];
            sp[u][i] = ok ? (fmaxf(z, 0.f) + flog(1.0f + fexp(-fabsf(z)))) : 0.f; }
        suf[u][3] = sp[u][3]; suf[u][2] = sp[u][2] + suf[u][3]; suf[u][1] = sp[u][1] + suf[u][2]; suf[u][0] = sp[u][0] + suf[u][1];
        const float T = suf[u][0], t1 = __shfl_xor(T, 16), t2 = __shfl_xor(T, 32), t3 = __shfl_xor(T, 48);
        later[u] = ((fq ^ 1) > fq ? t1 : 0.f) + ((fq ^ 2) > fq ? t2 : 0.f) + ((fq ^ 3) > fq ? t3 : 0.f);
        tot[u] = (T + t1) + (t2 + t3);
    }
    f32x4 w[2];
#pragma unroll
    for (int i = 0; i < 4; ++i) {
        const bool ok1 = (vmask >> (4 + i)) & 1u, ok0 = (vmask >> i) & 1u;
        w[1][i] = ok1 ? fexp(s[1][0][i] - (R + later[1] + suf[1][i])) : 0.f;
        w[0][i] = ok0 ? fexp(s[0][0][i] - (R + tot[1] + later[0] + suf[0][i])) : 0.f;
    }
    R += tot[0] + tot[1];
    pf = pack8(w[0], w[1]);
}
template <int HD, int QB> __device__ __forceinline__ void store_o(const f32x4 (&o)[HD / 16][QB], const float (&inv)[QB], bf16* ao  , int nq, int fr, int fq) {
    asm volatile("" : "+v"(fr), "+v"(fq));
#pragma unroll
    for (int qb = 0; qb < QB; ++qb)
#pragma unroll
        for (int c = 0; c < HD / 16; ++c) { const f32x4 x = o[c][qb] * inv[qb]; u32x2 w; w.x = pkbf(x.x, x.y); w.y = pkbf(x.z, x.w);
            if (16 * qb + fr < nq) *(u32x2*)(ao + (size_t)(16 * qb + fr) * AOW + 16 * c + 4 * fq) = w; }
}

template <int QB> __device__ __forceinline__ void bias_and_mask(f32x4 (&s)[2][QB], unsigned (&vmask)[QB], const float* relb, int qpos0, int key0, int nvalid, int kpos, int fr, int fq) {
#pragma unroll
    for (int qb = 0; qb < QB; ++qb) { unsigned vm = 0u;
#pragma unroll
        for (int u = 0; u < 2; ++u)
#pragma unroll
            for (int i = 0; i < 4; ++i) { const int kk = key0 + 16 * u + 4 * fq + i; if (kk < nvalid) vm |= 1u << (4 * u + i);
                if (relb) { int rel = (qpos0 + 16 * qb + fr) - (kpos + kk); rel = rel < -128 ? -128 : (rel > 128 ? 128 : rel); s[u][qb][i] += relb[rel + 128]; } }
        vmask[qb] = vm; }
}
template <int QB, bool SEG1, int NSPLIT>
__device__ __forceinline__ void softmax_item(const bf16* q, int qpos0, bf16* ao,
                                             const char* k1, const char* v1, size_t pitch1, int k1lo, int k1hi, int n1, int kpos1,
                                             const char* k2, const char* v2, size_t pitch2, int k2lo, int k2hi, int n2, int kpos2,
                                             const float* relb, LAS char* lds0, int wave, int lane) {
    constexpr int HD = 128;
    const int fr = lane & 15, fq = lane >> 4;
    LAS char* vt = lds0 + wave * VT_STRIDE;
    bf16x8 qf[QB][HD / 32]; load_q<HD, QB>(qf, q, fr, fq);
    f32x4 o[HD / 16][QB]; float m[QB], l[QB];
#pragma unroll
    for (int qb = 0; qb < QB; ++qb) { m[qb] = -1e30f; l[qb] = 0.f;
#pragma unroll
        for (int c = 0; c < HD / 16; ++c) o[c][qb] = (f32x4){0.f, 0.f, 0.f, 0.f}; }
    f32x4 s[2][QB]; bf16x8 pf[QB]; unsigned vmask[QB];
    if constexpr (SEG1) {
        for (int key0 = k1lo; key0 < k1hi; key0 += 32) {
            qk_tile<HD, QB, true>(s, qf, k1, pitch1, key0, n1 - 1, fr, fq);
            stage_v<HD, true>(vt, v1, pitch1, key0, n1 - 1, lane);
            bias_and_mask<QB>(s, vmask, relb, qpos0, key0, n1, kpos1, fr, fq);
            softmax_step<HD, QB>(s, vmask, m, l, o, pf);
            pv_tile<HD, QB>(o, pf, vt, lane);
        }
    }
    for (int key0 = k2lo; key0 < k2hi; key0 += 32) {
        qk_tile<HD, QB, false>(s, qf, k2, pitch2, key0, n2 - 1, fr, fq);
        stage_v<HD, false>(vt, v2, pitch2, key0, n2 - 1, lane);
        bias_and_mask<QB>(s, vmask, relb, qpos0, key0, n2, kpos2, fr, fq);
        softmax_step<HD, QB>(s, vmask, m, l, o, pf);
        pv_tile<HD, QB>(o, pf, vt, lane);
    }
#pragma unroll
    for (int qb = 0; qb < QB; ++qb) { float t = l[qb]; t += __shfl_xor(t, 16); t += __shfl_xor(t, 32); l[qb] = t; }
    if constexpr (NSPLIT > 1) {
        static_assert(QB == 1, "split items are 16-query items");
        LAS f32x4* po = (LAS f32x4*)(vt + 9216);
#pragma unroll
        for (int c = 0; c < HD / 16; ++c) po[c * 64 + lane] = o[c][0];
        { LAS float* ml = (LAS float*)(lds0 + 139264 + 512 * wave); ml[lane] = m[0]; ml[64 + lane] = l[0]; }
        __syncthreads();
        if ((wave % NSPLIT) == 0) {
            float mk[NSPLIT], lk[NSPLIT], M = -1e30f;
#pragma unroll
            for (int k = 0; k < NSPLIT; ++k) { const LAS float* ml = (const LAS float*)(lds0 + 139264 + 512 * (wave + k)); mk[k] = ml[lane]; lk[k] = ml[64 + lane]; M = fmaxf(M, mk[k]); }
            float L = 0.f;
#pragma unroll
            for (int k = 0; k < NSPLIT; ++k) { mk[k] = fexp(mk[k] - M); L += lk[k] * mk[k]; }
#pragma unroll
            for (int c = 0; c < HD / 16; ++c) { f32x4 a = {0.f, 0.f, 0.f, 0.f};
#pragma unroll
                for (int k = 0; k < NSPLIT; ++k) a += ((const LAS f32x4*)(lds0 + (wave + k) * VT_STRIDE + 9216))[c * 64 + lane] * mk[k];
                o[c][0] = a; }
            const float inv[1] = {1.0f / L};
            store_o<HD, 1>(o, inv, ao, 16, fr, fq);
        }
        __syncthreads();
    } else {
        float inv[QB];
#pragma unroll
        for (int qb = 0; qb < QB; ++qb) inv[qb] = 1.0f / l[qb];
        store_o<HD, QB>(o, inv, ao, 16 * QB, fr, fq);
    }
}

constexpr int BPITCH = 272, BK_BYTES = 64 * BPITCH;
template <int QB> __device__ __forceinline__ void qk_tile_lds(f32x4 (&s)[2][QB], const bf16x8 (&qf)[QB][4], const LAS char* kt, int fr, int fq) {
#pragma unroll
    for (int u = 0; u < 2; ++u) {
        const LAS char* rp = kt + (16 * u + fr) * BPITCH + 16 * fq;
        bf16x8 kf[4];
#pragma unroll
        for (int ks = 0; ks < 4; ++ks) kf[ks] = *(const LAS bf16x8*)(rp + 64 * ks);
#pragma unroll
        for (int qb = 0; qb < QB; ++qb) { f32x4 a = {0.f, 0.f, 0.f, 0.f};
#pragma unroll
            for (int ks = 0; ks < 4; ++ks) a = MFMA16(kf[ks], qf[qb][ks], a);
            s[u][qb] = a; }
    }
}
template <bool BAND>
__device__ __forceinline__ void softmax_block(const bf16* q  , bf16* ao, const char* kbase, const char* vbase, size_t pitchB,
                                              int kc_lo, int kc_hi  , int c0  , const float* relb, LAS char* lds, int tid) {
    constexpr int HD = 128, QB = 2;
    const int lane = tid & 63, wave = __builtin_amdgcn_readfirstlane(tid >> 6), fr = lane & 15, fq = lane >> 4;
    const int srow = tid >> 4, sch = tid & 15;
    bf16x8 pk[2], pw[2];
#define SB_ISSUE(kc) do { _Pragma("unroll") for (int i_ = 0; i_ < 2; ++i_) { const size_t go_ = (size_t)((kc) * 64 + srow + 32 * i_) * pitchB + sch * 16; \
        pk[i_] = *(const bf16x8*)(kbase + go_); pw[i_] = *(const bf16x8*)(vbase + go_); } } while (0)
#define SB_WRITE(buf) do { _Pragma("unroll") for (int i_ = 0; i_ < 2; ++i_) { const int lo_ = (srow + 32 * i_) * BPITCH + sch * 16; \
        *(LAS bf16x8*)(lds + (buf) * BK_BYTES + lo_) = pk[i_]; *(LAS bf16x8*)(lds + (2 + (buf)) * BK_BYTES + lo_) = pw[i_]; } } while (0)
    SB_ISSUE(kc_lo);
    LAS float* bt = (LAS float*)(lds + 4 * BK_BYTES);
    if (BAND) for (int i = tid; i < 257; i += 512) bt[i] = relb[i];
    bf16x8 qf[QB][4]; load_q<HD, QB>(qf, q + (size_t)(32 * wave) * QKVW, fr, fq);
    f32x4 o[HD / 16][QB]; float m[QB], l[QB];
#pragma unroll
    for (int qb = 0; qb < QB; ++qb) { m[qb] = -1e30f; l[qb] = 0.f;
#pragma unroll
        for (int c = 0; c < HD / 16; ++c) o[c][qb] = (f32x4){0.f, 0.f, 0.f, 0.f}; }
    SB_WRITE(0);
    __syncthreads();
    const int cw = c0 + (wave >> 1), qp0 = c0 * 64 + 32 * wave;
    const unsigned vall[QB] = {0xffu, 0xffu};
    for (int kc = kc_lo; kc < kc_hi; ++kc) {
        const int buf = (kc - kc_lo) & 1;
        if (kc + 1 < kc_hi) SB_ISSUE(kc + 1);
        if (!BAND || (kc >= cw - 8 && kc <= cw)) {
#pragma unroll
            for (int sub = 0; sub < 2; ++sub) {
                f32x4 s[2][QB]; bf16x8 pf[QB];
                qk_tile_lds<QB>(s, qf, lds + buf * BK_BYTES + sub * 32 * BPITCH, fr, fq);
                if (BAND) {
                    const int kp0 = kc * 64 + sub * 32;
                    if (qp0 - (kp0 + 31) >= 128) { const float bfar = bt[256];
#pragma unroll
                        for (int qb = 0; qb < QB; ++qb)
#pragma unroll
                            for (int u = 0; u < 2; ++u) s[u][qb] += bfar;
                    } else {
#pragma unroll
                        for (int qb = 0; qb < QB; ++qb)
#pragma unroll
                            for (int u = 0; u < 2; ++u)
#pragma unroll
                                for (int i = 0; i < 4; ++i) { int rel = (qp0 + 16 * qb + fr) - (kp0 + 16 * u + 4 * fq + i); rel = rel < -128 ? -128 : (rel > 128 ? 128 : rel); s[u][qb][i] += bt[rel + 128]; }
                    }
                }
                softmax_step<HD, QB>(s, vall, m, l, o, pf);
                pv_tile<HD, QB, BPITCH>(o, pf, lds + (2 + buf) * BK_BYTES + sub * 32 * BPITCH, lane);
            }
        }
        if (kc + 1 < kc_hi) SB_WRITE(buf ^ 1);
        __syncthreads();
    }
#undef SB_ISSUE
#undef SB_WRITE
    float inv[QB];
#pragma unroll
    for (int qb = 0; qb < QB; ++qb) { float t = l[qb]; t += __shfl_xor(t, 16); t += __shfl_xor(t, 32); inv[qb] = 1.0f / t; }
    store_o<HD, QB>(o, inv, ao + (size_t)(32 * wave) * AOW, 32, fr, fq);
}

template <bool SEG1>
__device__ __forceinline__ void stick_item(const bf16* q, int q0, bf16* ao,
                                           const char* k1, const char* v1, size_t pitch1, int n1,
                                           const char* k2, const char* v2, size_t pitch2, int n2,
                                           LAS char* vt, int lane) {
    constexpr int HD = 256;
    const int fr = lane & 15, fq = lane >> 4;
    bf16x8 qf[1][HD / 32]; load_q<HD, 1>(qf, q, fr, fq);
    f32x4 o[HD / 16][1];
#pragma unroll
    for (int c = 0; c < HD / 16; ++c) o[c][0] = (f32x4){0.f, 0.f, 0.f, 0.f};
    float R = 0.f; f32x4 s[2][1]; bf16x8 pf[1]; bool done = false;
    for (int key0 = (q0 >> 5) << 5; key0 >= 0; key0 -= 32) {
        qk_tile<HD, 1, false>(s, qf, k2, pitch2, key0, n2 - 1, fr, fq);
        stage_v<HD, false>(vt, v2, pitch2, key0, n2 - 1, lane);
        unsigned vm = 0u;
#pragma unroll
        for (int u = 0; u < 2; ++u)
#pragma unroll
            for (int i = 0; i < 4; ++i) { const int kk = key0 + 16 * u + 4 * fq + i; if (kk < n2 && kk < q0 + fr) vm |= 1u << (4 * u + i); }
        stick_step(s, vm, R, pf[0], fq);
        pv_tile<HD, 1>(o, pf, vt, lane);
#if SB_EARLY
        if (__all(R > 110.0f)) { done = true; break; }
#endif
    }
    if constexpr (SEG1) {
        if (!done) for (int key0 = n1 - 32; key0 >= 0; key0 -= 32) {
            qk_tile<HD, 1, true>(s, qf, k1, pitch1, key0, n1 - 1, fr, fq);
            stage_v<HD, true>(vt, v1, pitch1, key0, n1 - 1, lane);
            stick_step(s, 0xffu, R, pf[0], fq);
            pv_tile<HD, 1>(o, pf, vt, lane);
#if SB_EARLY
            if (__all(R > 110.0f)) break;
#endif
        }
    }
    const float inv[1] = {1.0f};
    store_o<HD, 1>(o, inv, ao, 16, fr, fq);
}
}

__device__ __forceinline__ void p0_transpose_item(const float* W, int K, int N, bf16* WT, const float* gain, float scale, int ffn_up, LAS float* scr, int item, int lane) {
    const int nblk = N / 32, kb = item / nblk, nb = item % nblk, k0 = 64 * kb, n0 = 32 * nb;
    int r0 = n0;
    if (ffn_up) { const int j0 = n0 < DFF ? n0 : n0 - DFF; r0 = 256 * (j0 >> 7) + (n0 < DFF ? 0 : 128) + (j0 & 127); }
#pragma unroll 8
    for (int i = 0; i < 32; ++i) { const int kk = 2 * i + (lane >> 5); const float g = gain ? gain[k0 + kk] * scale : scale;
        scr[kk * 33 + (lane & 31)] = W[(size_t)(k0 + kk) * N + n0 + (lane & 31)] * g; }
    LDS_WAIT(); asm volatile("" ::: "memory");
    const int c = lane & 7;
#pragma unroll
    for (int j = 0; j < 4; ++j) { const int n = (lane >> 3) + 8 * j; const LAS float* s = scr + (8 * c) * 33 + n;
        u32x4 o; o.x = pkbf(s[0 * 33], s[1 * 33]); o.y = pkbf(s[2 * 33], s[3 * 33]); o.z = pkbf(s[4 * 33], s[5 * 33]); o.w = pkbf(s[6 * 33], s[7 * 33]);
        *(u32x4*)(WT + (size_t)(r0 + n) * K + k0 + 8 * c) = o; }
    LDS_WAIT(); asm volatile("" ::: "memory");
}
__device__ __forceinline__ float wave_sum(float v) {
#pragma unroll
    for (int o = 1; o < 64; o <<= 1) v += __shfl_xor(v, o);
    return v;
}
__device__ __forceinline__ void p0_row(const float* xrow, bf16* orow, float* ssq_row, int norm, int lane) {
    const f32x4* xr = (const f32x4*)xrow + lane;
    f32x4 v[8]; float s = 0.f;
#pragma unroll
    for (int j = 0; j < 8; ++j) { v[j] = xr[64 * j]; s += dot4(v[j]); }
    s = wave_sum(s);
    const float sc = norm ? __builtin_amdgcn_rsqf(s * (1.0f / DM) + EPS) : 1.0f;
    u32x2* o8 = (u32x2*)orow + lane;
#pragma unroll
    for (int j = 0; j < 8; ++j) { u32x2 w; w.x = pkbf(v[j].x * sc, v[j].y * sc); w.y = pkbf(v[j].z * sc, v[j].w * sc); o8[64 * j] = w; }
    if (ssq_row && lane < 8) ssq_row[lane] = lane == 0 ? s : 0.f;
}

struct Params { const float* in[25]; float* out; unsigned char* ws; int ph_lo, ph_hi, bar_idx, pad; };
__global__ void __launch_bounds__(512, 2) fwd(Params P) {
    extern __shared__ __attribute__((aligned(16))) unsigned char lds_raw[];
    LAS unsigned char* lds = (LAS unsigned char*)lds_raw;
    const int tid = threadIdx.x, lane = tid & 63, wave = __builtin_amdgcn_readfirstlane(tid >> 6);
    const int G = gridDim.x, gw = blockIdx.x * 8 + wave, NGW = G * 8;
    unsigned char* ws = P.ws; float* out = P.out;
    volatile LAS unsigned* MISC = (volatile LAS unsigned*)(lds + MISC_OFF);
    if (tid < 32) MISC[tid] = 0u;
    __syncthreads();
    unsigned* ctl = (unsigned*)(ws + WS_CTL);
    XcdBarrier bar; bar.bar = ctl + 4096; bar.x = 0; bar.st = nullptr;
    if (!MK_MULTI) bar = xcd_barrier_post(ctl + 4096, MISC + 8);
    const int lo = P.ph_lo, hi = P.ph_hi;
#define IN(k) (lo <= (k) && (k) < hi)
#define SEAM(k) do { if (IN(k) && IN((k) + 1)) xcd_barrier(bar); } while (0)
    bf16* XB = (bf16*)(ws + WS_XB); bf16* HB = (bf16*)(ws + WS_H); bf16* QKV = (bf16*)(ws + WS_QKV); bf16* AO = (bf16*)(ws + WS_AO); bf16* MKV = (bf16*)(ws + WS_MKV);
    float* SSQ = (float*)(ws + WS_SSQ);
    LAS float* TAB1 = (LAS float*)(lds + TAB1_OFF); LAS float* TAB2 = (LAS float*)(lds + TAB2_OFF);

    for (int rep = 0; rep < 1 + DUP_P0; ++rep) if (IN(0)) {
        LAS float* scr = (LAS float*)(lds + wave * 16384);
        constexpr int I_U = (DM / 64) * (2 * DFF / 32), I_D = (DFF / 64) * (DM / 32), I_IN = (DM / 64) * (QKVW / 32), I_MK = (DM / 64) * (1024 / 32), I_O = (AOW / 64) * (DM / 32);
        constexpr int I_LAYER = 2 * I_U + 2 * I_D + I_IN + I_MK + I_O, I_W = NLAYER * I_LAYER, I_ALL = I_W + MRX;
        for (int it = gw; it < I_ALL; it += NGW) {
            if (it < I_W) {
                const int l = it / I_LAYER; int r = it % I_LAYER;
                bf16* LW = (bf16*)(ws + WS_W + (size_t)l * LW_SIZE);
                if (r < I_U) { p0_transpose_item(P.in[10] + (size_t)l * DM * 2 * DFF, DM, 2 * DFF, (bf16*)((char*)LW + LW_1U), P.in[9] + l * DM, 1.0f, 1, scr, r, lane); continue; } r -= I_U;
                if (r < I_D) { p0_transpose_item(P.in[11] + (size_t)l * DFF * DM, DFF, DM, (bf16*)((char*)LW + LW_1D), nullptr, 0.5f, 0, scr, r, lane); continue; } r -= I_D;
                if (r < I_IN) { p0_transpose_item(P.in[13] + (size_t)l * DM * QKVW, DM, QKVW, (bf16*)((char*)LW + LW_IN), P.in[12] + l * DM, 1.0f, 0, scr, r, lane); continue; } r -= I_IN;
                if (r < I_MK) { p0_transpose_item(P.in[19] + (size_t)l * DM * 1024, DM, 1024, (bf16*)((char*)LW + LW_IN) + (size_t)QKVW * DM, P.in[18] + l * DM, 1.0f, 0, scr, r, lane); continue; } r -= I_MK;
                if (r < I_O) { p0_transpose_item(P.in[14] + (size_t)l * AOW * DM, AOW, DM, (bf16*)((char*)LW + LW_O), nullptr, 1.0f, 0, scr, r, lane); continue; } r -= I_O;
                if (r < I_U) { p0_transpose_item(P.in[23] + (size_t)l * DM * 2 * DFF, DM, 2 * DFF, (bf16*)((char*)LW + LW_2U), P.in[22] + l * DM, 1.0f, 1, scr, r, lane); continue; } r -= I_U;
                p0_transpose_item(P.in[24] + (size_t)l * DFF * DM, DFF, DM, (bf16*)((char*)LW + LW_2D), nullptr, 0.5f, 0, scr, r, lane);
            } else {
                const int m = it - I_W;
                const float* src = m < NP ? P.in[0] + (size_t)m * DM : m < MR ? P.in[1] + (size_t)(m - NP) * DM : P.in[2] + (size_t)(m - MR) * DM;
                p0_row(src, XB + (size_t)m * DM, m < MR ? SSQ + (size_t)m * 8 : nullptr, m >= MR, lane);
            }
        }
    }
    if (IN(0) && blockIdx.x == 0) {
        float* gd = (float*)(ws + WS_DBG);
        for (int i = tid; i < NLAYER * 512; i += 512) { const int l = i >> 9, k = (i >> 7) & 3, d = i & 127;
            gd[i] = k == 0 ? P.in[15][(l >> 1) * 128 + d] : k == 1 ? P.in[16][(l >> 1) * 128 + d] : k == 2 ? P.in[20][l * 128 + d] : P.in[21][l * 128 + d]; }
    }
    SEAM(0);

    for (int l = 0; l < NLAYER; ++l) {
        const int pb = 1 + 7 * l, e = l & 1, j = l >> 1;
        if (hi <= pb || lo >= pb + 7) continue;
        const char* LW = (const char*)(ws + WS_W + (size_t)l * LW_SIZE);
        float* ssqA = SSQ + (size_t)e * SSQ_BUF; float* ssqB = SSQ + (size_t)(1 - e) * SSQ_BUF;
        for (int rep = 0; rep < 1 + DUP_G1; ++rep) if (IN(pb + 0)) {
            pg8::Gemm g{XB, (const bf16*)(LW + LW_1U), MR, 2 * DFF, DM}; pg8::StaticOrder S; int bx = blockIdx.x; asm volatile("" : "+s"(bx)); S.init(MR, 2 * DFF, G, bx);
            EpiSwiGLU E{HB, ssqA};
            pg8::gemm_phase<EpiSwiGLU, pg8::StaticOrder, true, true>(lds, g, S, E);
        }
        SEAM(pb + 0);
        if (IN(pb + 1)) {
            pg8::Gemm g{HB, (const bf16*)(LW + LW_1D), MR, DM, DFF}; pg8::StaticOrder S; int bx = blockIdx.x; asm volatile("" : "+s"(bx)); S.init(MR, DM, G, bx);
            EpiResid E{l == 0 ? P.in[0] : out, l == 0 ? P.in[1] : out + (size_t)NP * DM, out, XB, ssqB, TAB1};
            pg8::gemm_phase<EpiResid, pg8::StaticOrder, true, true>(lds, g, S, E);
        }
        SEAM(pb + 1);
        for (int rep = 0; rep < 1 + DUP_G3; ++rep) if (IN(pb + 2)) {
            pg8::Gemm g{XB, (const bf16*)(LW + LW_IN), MRX, INW, DM}; G3Order S; int bx = blockIdx.x; asm volatile("" : "+s"(bx)); S.init(G, bx);
            EpiQKV E{QKV, MKV + (size_t)l * NMR * 1024, ssqB, (const float*)(ws + WS_DBG) + l * 512, out, l, TAB2};
            pg8::gemm_phase<EpiQKV, G3Order, true, true>(lds, g, S, E);
        }
        SEAM(pb + 2);
        for (int rep = 0; rep < 1 + (e ? DUP_ATTB : DUP_ATTA); ++rep) if (IN(pb + 3)) {
            int tid_ = threadIdx.x; asm volatile("" : "+v"(tid_)); __builtin_assume(tid_ >= 0 && tid_ < 512);
            const int tid = tid_, lane = tid_ & 63;
            LAS char* vt = (LAS char*)lds + wave * VT_STRIDE;
            const bf16* mkv = MKV + (size_t)l * NMR * 1024;
            if (!e) {
                const float* relb = P.in[17] + (size_t)j * 8 * 257;
                for (int it = blockIdx.x; it < NB * 8 * (SEQ / 256); it += G) {
                    const int qb = it % (SEQ / 256), h = (it / (SEQ / 256)) % 8, b = it / (8 * (SEQ / 256)), c0 = qb * 4;
                    const bf16* rowb = QKV + (size_t)b * SEQ * QKVW;
                    att::softmax_block<true>(rowb + (size_t)(qb * 256) * QKVW + h * 128, AO + (size_t)(b * SEQ + qb * 256) * AOW + h * 128,
                                             (const char*)(rowb + TOKW + h * 128), (const char*)(rowb + 2 * TOKW + h * 128), (size_t)QKVW * 2,
                                             c0 >= 8 ? c0 - 8 : 0, c0 + 4, c0, relb + h * 257, (LAS char*)lds, tid);
                }
                for (int it0 = blockIdx.x * 2; it0 < DBAT * 8; it0 += G * 2) {
                    const int it = it0 + (wave >> 2), sp = wave & 3, h = it % 8, sb = it / 8;
                    const bf16* rowb = QKV + (size_t)(NP + sb * DSEQ) * QKVW;
                    const float* ck = P.in[3] + ((size_t)(j * DBAT + sb) * ACACHE) * TOKW + h * 128; const float* cv = P.in[4] + ((size_t)(j * DBAT + sb) * ACACHE) * TOKW + h * 128;
                    att::softmax_item<1, true, 4>(rowb + h * 128, PAST, AO + (size_t)(NP + sb * DSEQ) * AOW + h * 128,
                                                  (const char*)ck, (const char*)cv, (size_t)TOKW * 4, sp * 128, sp * 128 + 128, ACACHE, PAST - ACACHE,
                                                  (const char*)(rowb + TOKW + h * 128), (const char*)(rowb + 2 * TOKW + h * 128), (size_t)QKVW * 2, 0, sp == 3 ? 32 : 0, DSEQ, PAST,
                                                  relb + h * 257, (LAS char*)lds, wave, lane);
                }
            } else {
                constexpr int NIT = NB * 4 * (SEQ / 16);
                for (int r = 0; r * NGW < NIT; ++r) {
                    const int p = (r & 1) ? (r + 1) * NGW - 1 - gw : r * NGW + gw; if (p >= NIT) continue;
                    const int qi = (SEQ / 16) - 1 - p / 8, bh = p % 8, b = bh >> 2, h = bh & 3, q0 = qi * 16;
                    const bf16* rowb = QKV + (size_t)b * SEQ * QKVW;
                    att::stick_item<false>(rowb + (size_t)q0 * QKVW + h * 256, q0, AO + (size_t)(b * SEQ + q0) * AOW + h * 256,
                                           nullptr, nullptr, 0, 0,
                                           (const char*)(rowb + TOKW + h * 256), (const char*)(rowb + 2 * TOKW + h * 256), (size_t)QKVW * 2, SEQ, vt, lane);
                }
                for (int it = gw; it < DBAT * 4; it += NGW) {
                    const int h = it % 4, sb = it / 4;
                    const bf16* rowb = QKV + (size_t)(NP + sb * DSEQ) * QKVW;
                    const float* ck = P.in[5] + ((size_t)(j * DBAT + sb) * PAST) * TOKW + h * 256; const float* cv = P.in[6] + ((size_t)(j * DBAT + sb) * PAST) * TOKW + h * 256;
                    att::stick_item<true>(rowb + h * 256, 0, AO + (size_t)(NP + sb * DSEQ) * AOW + h * 256,
                                          (const char*)ck, (const char*)cv, (size_t)TOKW * 4, PAST,
                                          (const char*)(rowb + TOKW + h * 256), (const char*)(rowb + 2 * TOKW + h * 256), (size_t)QKVW * 2, DSEQ, vt, lane);
                }
            }
            __syncthreads();
            for (int it = blockIdx.x; it < NB * 4 * (SEQ / 256); it += G) {
                const int qb = it % (SEQ / 256), h = (it / (SEQ / 256)) % 4, b = it / (4 * (SEQ / 256));
                const bf16* kb = mkv + (size_t)b * NMEM * 1024 + h * 128;
                att::softmax_block<false>(QKV + (size_t)(b * SEQ + qb * 256) * QKVW + 3 * TOKW + h * 128, AO + (size_t)(b * SEQ + qb * 256) * AOW + TOKW + h * 128,
                                          (const char*)kb, (const char*)(kb + MEMW), (size_t)1024 * 2, 0, NMEM / 64, 0, nullptr, (LAS char*)lds, tid);
            }
            for (int it0 = blockIdx.x * 2; it0 < DBAT * 4; it0 += G * 2) {
                const int it = it0 + (wave >> 2), sp = wave & 3, h = it % 4, sb = it / 4;
                const float* ck = P.in[7] + ((size_t)(l * DBAT + sb) * NMEM) * MEMW + h * 128; const float* cv = P.in[8] + ((size_t)(l * DBAT + sb) * NMEM) * MEMW + h * 128;
                att::softmax_item<1, true, 4>(QKV + (size_t)(NP + sb * DSEQ) * QKVW + 3 * TOKW + h * 128, 0, AO + (size_t)(NP + sb * DSEQ) * AOW + TOKW + h * 128,
                                              (const char*)ck, (const char*)cv, (size_t)MEMW * 4, sp * 64, sp * 64 + 64, NMEM, 0,
                                              nullptr, nullptr, 0, 0, 0, 1, 0, nullptr, (LAS char*)lds, wave, lane);
            }
        }
        SEAM(pb + 3);
        if (IN(pb + 4)) {
            pg8::Gemm g{AO, (const bf16*)(LW + LW_O), MR, DM, AOW}; pg8::StaticOrder S; int bx = blockIdx.x; asm volatile("" : "+s"(bx)); S.init(MR, DM, G, bx);
            EpiResid E{out, out + (size_t)NP * DM, out, XB, ssqA, TAB1};
            pg8::gemm_phase<EpiResid, pg8::StaticOrder, true, true>(lds, g, S, E);
        }
        SEAM(pb + 4);
        if (IN(pb + 5)) {
            pg8::Gemm g{XB, (const bf16*)(LW + LW_2U), MR, 2 * DFF, DM}; pg8::StaticOrder S; int bx = blockIdx.x; asm volatile("" : "+s"(bx)); S.init(MR, 2 * DFF, G, bx);
            EpiSwiGLU E{HB, ssqA};
            pg8::gemm_phase<EpiSwiGLU, pg8::StaticOrder, true, true>(lds, g, S, E);
        }
        SEAM(pb + 5);
        if (IN(pb + 6)) {
            pg8::Gemm g{HB, (const bf16*)(LW + LW_2D), MR, DM, DFF}; pg8::StaticOrder S; int bx = blockIdx.x; asm volatile("" : "+s"(bx)); S.init(MR, DM, G, bx);
            EpiResid E{out, out + (size_t)NP * DM, out, XB, ssqB, TAB1};
            pg8::gemm_phase<EpiResid, pg8::StaticOrder, true, true>(lds, g, S, E);
        }
        SEAM(pb + 6);
    }
#undef IN
#undef SEAM
}

extern "C" void kernel_launch(void* const* d_in, const int* in_sizes, int n_in, void* d_out, int out_size, void* d_ws, size_t ws_size, hipStream_t stream) {
    static int grid = 0;
    if (grid == 0) {
        if (n_in != 25 || (size_t)out_size != O_END || ws_size < WS_END) { fprintf(stderr, "kernel_launch: unexpected shapes (n_in %d out %d ws %zu)\n", n_in, out_size, ws_size); grid = -1; return; }
        int dev = 0, cus = 0, per_cu = 0;
        if (hipGetDevice(&dev) != hipSuccess || hipDeviceGetAttribute(&cus, hipDeviceAttributeMultiprocessorCount, dev) != hipSuccess) { grid = -1; return; }
        if (hipFuncSetAttribute((const void*)fwd, hipFuncAttributeMaxDynamicSharedMemorySize, LDS_BYTES) != hipSuccess) { fprintf(stderr, "kernel_launch: hipFuncSetAttribute failed\n"); grid = -1; return; }
        if (hipOccupancyMaxActiveBlocksPerMultiprocessor(&per_cu, (const void*)fwd, 512, LDS_BYTES) != hipSuccess || per_cu < 1) { fprintf(stderr, "kernel_launch: occupancy query says %d\n", per_cu); (void)hipGetLastError(); grid = -1; return; }
        grid = cus;
    }
    if (grid < 0) return;
    (void)hipMemsetAsync((char*)d_ws + WS_CTL, 0, CTL_ZERO_BYTES, stream);
    Params p; memset(&p, 0, sizeof(p));
    for (int i = 0; i < 25; ++i) p.in[i] = (const float*)d_in[i];
    p.out = (float*)d_out; p.ws = (unsigned char*)d_ws;
#if MK_MULTI
    for (int k = 0; k < NPH; ++k) { p.ph_lo = k; p.ph_hi = k + 1; hipLaunchKernelGGL(fwd, dim3(grid), dim3(512), LDS_BYTES, stream, p); }
#else
    p.ph_lo = 0; p.ph_hi = NPH; hipLaunchKernelGGL(fwd, dim3(grid), dim3(512), LDS_BYTES, stream, p);
#endif
}
```

```cpp
#include <hip/hip_runtime.h>
#include <cstdio>
#include <cstdint>
#include <cstring>
#ifndef MK_MULTI
#define MK_MULTI 0
#endif
#ifndef SB_EARLY
#define SB_EARLY 1
#endif
#ifndef DUP_P0
#define DUP_P0 0
#endif
#ifndef DUP_G1
#define DUP_G1 0
#endif
#ifndef DUP_G3
#define DUP_G3 0
#endif
#ifndef DUP_ATTA
#define DUP_ATTA 0
#endif
#ifndef DUP_ATTB
#define DUP_ATTB 0
#endif
#ifndef STAGGER_US
#define STAGGER_US 0
#endif
namespace pg8 {
#define PG8_LAS __attribute__((address_space(3)))
typedef unsigned short bf16_t;
typedef short bf16x8 __attribute__((ext_vector_type(8)));
typedef float f32x4 __attribute__((ext_vector_type(4)));
typedef unsigned u32x4 __attribute__((ext_vector_type(4)));
constexpr int BM = 256, BK = 64, HALF = 128, HTB = HALF * BK * 2  , STAGE_BYTES = 8 * HTB, NXCD = 8, WGM = 8;

__host__ __device__ __forceinline__ int lds_byte(int r, int c) { const int st = (r >> 4) * 2 + (c >> 5), rr = r & 15, cc = c & 31, ob = rr * 64 + cc * 2; return st * 1024 + (ob ^ (((ob >> 9) & 1) << 5)); }
__host__ __device__ __forceinline__ void stage_rc(int b, int& R, int& C) { const int st = b / 1024, sb = b % 1024, swz = sb ^ (((sb >> 9) & 1) << 5); R = (st >> 1) * 16 + swz / 64; C = (st & 1) * 32 + (swz % 64) / 2; }
__host__ __device__ __forceinline__ int perm32(int rho) { const int n = rho >> 4, i = rho & 15; return 8 * (i >> 2) + 4 * n + (i & 3); }

struct Unit { int pm, pn; };
struct Gemm { const bf16_t* A; const bf16_t* Bt; int M, N, K; };

struct StaticOrder {
    int nM, nN, nwg, G, c;
    __host__ __device__ void init(int M, int N, int G_, int c_) { nM = M / BM; nN = N / BM; nwg = nM * nN; G = G_; c = c_; }
    __host__ __device__ bool next(int i, Unit& u) const {
        const long L = (long)i * G + c; if (L >= nwg) return false;
        int wgid = (int)L; { const int q = nwg / NXCD, r = nwg % NXCD, xcd = wgid % NXCD, off = wgid / NXCD; wgid = (xcd < r ? xcd * (q + 1) : r * (q + 1) + (xcd - r) * q) + off; }
        const int nig = WGM * nN, gid = wgid / nig, fm = gid * WGM, gsz = (nM - fm) < WGM ? (nM - fm) : WGM;
        u.pm = fm + ((wgid % nig) % gsz); u.pn = (wgid % nig) / gsz; return true;
    }
    __device__ __forceinline__ void a_ready(const Unit&) const {}
    __device__ __forceinline__ void done(const Unit&) const {}
};

__device__ __forceinline__ unsigned cvt_pk_bf16(float lo, float hi) { unsigned r; asm volatile("v_cvt_pk_bf16_f32 %0, %1, %2" : "=v"(r) : "v"(lo), "v"(hi)); return r; }
typedef float f32x2 __attribute__((ext_vector_type(2)));
template <class Epi, class Sched, bool ALIGN_EPI = false, bool SP2 = false, bool APAIR = false>
__device__ __forceinline__ void gemm_phase(PG8_LAS unsigned char* lds, const Gemm g, const Sched& S, const Epi& E, int& tid_) {
    asm volatile("" : "+v"(tid_));
    const int tid = tid_, wid = __builtin_amdgcn_readfirstlane(tid >> 6), lane = tid & 63, wr = wid >> 2, wc = wid & 3, fr = lane & 15, fq = lane >> 4;
    const int K = g.K, nt = K / BK;
    unsigned voffA[2], voffB[2];
#pragma unroll
    for (int i = 0; i < 2; ++i) { int R, C; stage_rc(tid * 16 + i * 8192, R, C); const int Rb = Epi::ADJ ? (64 * (R >> 5) + perm32(R & 31)) : Epi::PERM ? ((R & ~31) + perm32(R & 31)) : R;
        voffA[i] = APAIR ? (unsigned)((R >> 4) * (16 * K * 2) + (R & 7) * (2 * K * 2) + ((C * 2) >> 6) * 128 + ((R >> 3) & 1) * 64 + ((C * 2) & 63)) : (unsigned)(R * K + C) * 2u;
        voffB[i] = (unsigned)(Rb * K + C) * 2u; }
    const size_t kstep = (size_t)(BK * 2);
    const size_t kstepA = APAIR ? 2 * kstep : kstep;
    const size_t hstep = (size_t)HALF * K * 2;
    const size_t tstep = 2 * hstep;
    const size_t hstepB = Epi::ADJ ? (size_t)32 * K * 2 : hstep;
    const unsigned ldsw = (unsigned)wid * 1024u;
    const int aoff = lds_byte(wr * 64 + fr, fq * 8), boff = lds_byte(wc * 32 + fr, fq * 8);
#define PG8_SA(b, h) (((b) * 2 + (h)) * HTB)
#define PG8_SB(b, h) ((4 + (b) * 2 + (h)) * HTB)
#define PG8_STAGE(bufoff, gbase, voff) do { _Pragma("unroll") for (int _i = 0; _i < 2; ++_i) \
        __builtin_amdgcn_global_load_lds((const unsigned*)((const char*)(gbase) + (voff)[_i]), (PG8_LAS unsigned*)(lds + (bufoff) + ldsw + _i * 8192), 16, 0, 0); } while (0)
#define PG8_LDA(dst, b, h) do { _Pragma("unroll") for (int m = 0; m < 4; ++m) _Pragma("unroll") for (int k = 0; k < 2; ++k) dst[m][k] = *(const PG8_LAS bf16x8*)(lds + PG8_SA(b, h) + aoff + m * 2048 + k * 1024); } while (0)
#define PG8_LDB(dst, b, h) do { _Pragma("unroll") for (int n = 0; n < 2; ++n) _Pragma("unroll") for (int k = 0; k < 2; ++k) dst[n][k] = *(const PG8_LAS bf16x8*)(lds + PG8_SB(b, h) + boff + n * 2048 + k * 1024); } while (0)
#define PG8_MMA(ai, bj, At, Bt) do { __builtin_amdgcn_s_setprio(1); _Pragma("unroll") for (int m = 0; m < 4; ++m) _Pragma("unroll") for (int n = 0; n < 2; ++n) _Pragma("unroll") for (int k = 0; k < 2; ++k) \
        acc[ai][bj][m][n] = __builtin_amdgcn_mfma_f32_16x16x32_bf16(Bt[n][k], At[m][k], acc[ai][bj][m][n], 0, 0, 0); __builtin_amdgcn_s_setprio(0); } while (0)
#define PG8_WAIT_V(n) asm volatile("s_waitcnt vmcnt(" #n ")" ::: "memory")
#define PG8_WAIT_L(n) asm volatile("s_waitcnt lgkmcnt(" #n ")" ::: "memory")
#define PG8_BAR __builtin_amdgcn_s_barrier()
#define PG8_SCHED __builtin_amdgcn_sched_barrier(0)
    Unit cur, nxt; int ui = 0;
    if (!S.next(0, cur)) return;
    f32x4 acc[2][2][4][2];
#pragma unroll
    for (int a = 0; a < 2; ++a)
#pragma unroll
        for (int b = 0; b < 2; ++b)
#pragma unroll
            for (int m = 0; m < 4; ++m)
#pragma unroll
                for (int n = 0; n < 2; ++n) acc[a][b][m][n] = (f32x4){0.f, 0.f, 0.f, 0.f};
    bf16x8 At[4][2], B0[2][2], B1[2][2];
    const char* cA = (const char*)g.A + (size_t)cur.pm * tstep; const char* cB = (const char*)g.Bt + (size_t)cur.pn * tstep;
    S.a_ready(cur);
    if constexpr (SP2) {
        PG8_STAGE(PG8_SB(0, 0), cB, voffB); PG8_STAGE(PG8_SB(0, 1), cB + hstepB, voffB); PG8_STAGE(PG8_SA(0, 0), cA, voffA); PG8_STAGE(PG8_SA(0, 1), cA + hstep, voffA);
        if (wr == 1) PG8_BAR;
        PG8_WAIT_V(2); PG8_BAR;
        PG8_STAGE(PG8_SB(1, 0), cB + kstep, voffB); PG8_STAGE(PG8_SA(1, 0), cA + kstepA, voffA); PG8_STAGE(PG8_SB(1, 1), cB + hstepB + kstep, voffB);
        PG8_WAIT_V(6); PG8_BAR;
    } else {
        PG8_STAGE(PG8_SB(0, 0), cB, voffB); PG8_STAGE(PG8_SA(0, 0), cA, voffA); PG8_STAGE(PG8_SB(0, 1), cB + hstepB, voffB); PG8_STAGE(PG8_SA(0, 1), cA + hstep, voffA);
        if (wr == 1) PG8_BAR;
        PG8_WAIT_V(4); PG8_BAR;
        PG8_STAGE(PG8_SB(1, 0), cB + kstep, voffB); PG8_STAGE(PG8_SA(1, 0), cA + kstepA, voffA); PG8_STAGE(PG8_SB(1, 1), cB + hstepB + kstep, voffB);
        PG8_WAIT_V(6); PG8_BAR;
    }
    for (;;) {
        const bool has_next = S.next(ui + 1, nxt);
        const char* nA = has_next ? (const char*)g.A + (size_t)nxt.pm * tstep : cA; const char* nB = has_next ? (const char*)g.Bt + (size_t)nxt.pn * tstep : cB;
        for (int t = 0; t < nt; t += 2) {
            const bool last = (t == nt - 2);
            const char* a1 = cA + (size_t)(t + 1) * kstepA;
            const char* a2 = last ? nA : cA + (size_t)(t + 2) * kstepA; const char* b2 = last ? nB : cB + (size_t)(t + 2) * kstep;
            const char* a3 = a2 + kstepA; const char* b3 = b2 + kstep;
            if constexpr (Epi::PREFETCH) { if (last) E.prefetch(cur, lds, tid, wid); }
            if (last && has_next) S.a_ready(nxt);
            if constexpr (SP2) {
            PG8_LDB(B0, 0, 0); PG8_LDB(B1, 0, 1); PG8_SCHED; PG8_LDA(At, 0, 0); PG8_STAGE(PG8_SA(1, 1), a1 + hstep, voffA);
            PG8_WAIT_V(8); PG8_WAIT_L(0); PG8_BAR; PG8_MMA(0, 0, At, B0); PG8_MMA(0, 1, At, B1); PG8_BAR; PG8_SCHED;
            PG8_LDA(At, 0, 1); PG8_STAGE(PG8_SB(0, 0), b2, voffB); PG8_STAGE(PG8_SB(0, 1), b2 + hstepB, voffB); PG8_STAGE(PG8_SA(0, 0), a2, voffA);
            PG8_WAIT_V(8); PG8_WAIT_L(0); PG8_BAR; PG8_MMA(1, 0, At, B0); PG8_MMA(1, 1, At, B1); PG8_BAR; PG8_SCHED;
            PG8_LDB(B0, 1, 0); PG8_LDB(B1, 1, 1); PG8_SCHED; PG8_LDA(At, 1, 0); PG8_STAGE(PG8_SA(0, 1), a2 + hstep, voffA);
            PG8_WAIT_V(8); PG8_WAIT_L(0); PG8_BAR; PG8_MMA(0, 0, At, B0); PG8_MMA(0, 1, At, B1); PG8_BAR; PG8_SCHED;
            PG8_LDA(At, 1, 1); PG8_STAGE(PG8_SB(1, 0), b3, voffB); PG8_STAGE(PG8_SB(1, 1), b3 + hstepB, voffB); PG8_STAGE(PG8_SA(1, 0), a3, voffA);
            PG8_WAIT_V(8); PG8_WAIT_L(0); PG8_BAR; PG8_MMA(1, 0, At, B0); PG8_MMA(1, 1, At, B1); PG8_BAR; PG8_SCHED;
            } else {
            PG8_LDB(B0, 0, 0); PG8_SCHED; PG8_LDA(At, 0, 0); PG8_STAGE(PG8_SA(1, 1), a1 + hstep, voffA);
            PG8_WAIT_L(8); PG8_BAR; PG8_WAIT_L(0); PG8_MMA(0, 0, At, B0); PG8_BAR; PG8_SCHED;
            PG8_LDB(B1, 0, 1); PG8_STAGE(PG8_SB(0, 0), b2, voffB);
            PG8_BAR; PG8_WAIT_L(0); PG8_MMA(0, 1, At, B1); PG8_BAR;
            PG8_LDA(At, 0, 1); PG8_STAGE(PG8_SA(0, 0), a2, voffA);
            PG8_BAR; PG8_WAIT_L(0); PG8_MMA(1, 0, At, B0); PG8_BAR; PG8_SCHED;
            PG8_STAGE(PG8_SB(0, 1), b2 + hstepB, voffB);
            PG8_WAIT_V(6); PG8_BAR; PG8_MMA(1, 1, At, B1); PG8_BAR;
            PG8_LDB(B0, 1, 0); PG8_SCHED; PG8_LDA(At, 1, 0); PG8_STAGE(PG8_SA(0, 1), a2 + hstep, voffA);
            PG8_WAIT_L(8); PG8_BAR; PG8_WAIT_L(0); PG8_MMA(0, 0, At, B0); PG8_BAR; PG8_SCHED;
            PG8_LDB(B1, 1, 1); PG8_STAGE(PG8_SB(1, 0), b3, voffB);
            PG8_BAR; PG8_WAIT_L(0); PG8_MMA(0, 1, At, B1); PG8_BAR;
            PG8_LDA(At, 1, 1); PG8_STAGE(PG8_SA(1, 0), a3, voffA);
            PG8_BAR; PG8_WAIT_L(0); PG8_MMA(1, 0, At, B0); PG8_BAR; PG8_SCHED;
            PG8_STAGE(PG8_SB(1, 1), b3 + hstepB, voffB);
            PG8_WAIT_V(6); PG8_BAR; PG8_MMA(1, 1, At, B1); PG8_BAR;
            }
        }
        if constexpr (ALIGN_EPI) { if (wr == 0) PG8_BAR; }
        if constexpr (!Epi::AFTER_DRAIN) { E(acc, cur, wr, wc, fr, fq); S.done(cur); }
        if (!has_next) break;
#pragma unroll
        for (int a = 0; a < 2; ++a)
#pragma unroll
            for (int b = 0; b < 2; ++b)
#pragma unroll
                for (int m = 0; m < 4; ++m)
#pragma unroll
                    for (int n = 0; n < 2; ++n) acc[a][b][m][n] = (f32x4){0.f, 0.f, 0.f, 0.f};
        cur = nxt; cA = nA; cB = nB; ++ui;
        if constexpr (ALIGN_EPI) { if (wr == 1) PG8_BAR; }
    }
    PG8_WAIT_V(0);
    if constexpr (!ALIGN_EPI) { if (wr == 0) PG8_BAR; }
    PG8_BAR;
    if constexpr (Epi::AFTER_DRAIN) { E.fused(acc, cur, wr, wc, fr, fq, lds, wid, lane); S.done(cur); }
#undef PG8_SA
#undef PG8_SB
#undef PG8_STAGE
#undef PG8_LDA
#undef PG8_LDB
#undef PG8_MMA
#undef PG8_WAIT_V
#undef PG8_WAIT_L
#undef PG8_BAR
#undef PG8_SCHED
}
}


#define GAS __attribute__((address_space(1)))
#define LAS __attribute__((address_space(3)))
typedef unsigned short bf16;
typedef float f32x4 __attribute__((ext_vector_type(4)));
typedef short bf16x8 __attribute__((ext_vector_type(8)));
typedef short s16x4 __attribute__((ext_vector_type(4)));
typedef unsigned u32x4 __attribute__((ext_vector_type(4)));
typedef unsigned u32x2 __attribute__((ext_vector_type(2)));
constexpr int DM = 2048, DFF = 3072, SEQ = 16384, NB = 2, NP = NB * SEQ, DBAT = 32, DSEQ = 16, NS = DBAT * DSEQ, MR = NP + NS;
constexpr int NMEM = 256, NMR = NB * NMEM, MRX = MR + NMR;
constexpr int QKVW = 3584, AOW = 1536, INW = 4608, TOKW = 1024, MEMW = 512;
constexpr int PAST = 1024, ACACHE = 512, NLAYER = 4;
constexpr float EPS = 1e-6f;
constexpr int NPH = 1 + 7 * NLAYER;
constexpr size_t O_Y = 0, O_AKP = (size_t)MR * DM, O_AVP = O_AKP + 2097152, O_BKP = O_AVP + 2097152, O_BVP = O_BKP + 67108864, O_MKP = O_BVP + 67108864,
                 O_MVP = O_MKP + 1048576, O_AKS = O_MVP + 1048576, O_AVS = O_AKS + 1048576, O_BKS = O_AVS + 1048576, O_BVS = O_BKS + 1048576, O_END = O_BVS + 1048576;
static_assert(O_END == 212860928, "output size");
constexpr size_t MiB = 1u << 20;
constexpr size_t WS_CTL = 0, CTL_ZERO_BYTES = 1 * MiB;
constexpr size_t LW_1U = 0, LW_1D = LW_1U + (size_t)2 * DFF * DM * 2, LW_IN = LW_1D + (size_t)DM * DFF * 2, LW_O = LW_IN + (size_t)INW * DM * 2, LW_2U = LW_O + (size_t)DM * AOW * 2,
                 LW_2D = LW_2U + (size_t)2 * DFF * DM * 2, LW_SIZE = LW_2D + (size_t)DM * DFF * 2;
static_assert(LW_SIZE == 96 * MiB, "per-layer weight bytes");
constexpr size_t WS_W = 1 * MiB, WS_XB = WS_W + NLAYER * LW_SIZE, WS_H = WS_XB + 132 * MiB, WS_QKV = WS_H + 195 * MiB, WS_AO = WS_QKV + 228 * MiB, WS_MKV = WS_AO + 98 * MiB,
                 WS_SSQ = WS_MKV + 4 * MiB, WS_DBG = WS_SSQ + 3 * MiB, WS_END = WS_DBG + 1 * MiB;
static_assert((size_t)MRX * DM * 2 <= 132 * MiB && (size_t)MR * DFF * 2 <= 195 * MiB && (size_t)MR * QKVW * 2 <= 228 * MiB && (size_t)MR * AOW * 2 <= 98 * MiB, "ws map");
constexpr size_t SSQ_BUF = (size_t)MR * 8;
constexpr int RING_BYTES = 131072, TAB1_OFF = 131072  , TAB2_OFF = 135168  , MISC_OFF = 143360, TAB3_OFF = 147456  , LDS_BYTES = 155648;
constexpr int VT_STRIDE = 17408;
static_assert(8 * VT_STRIDE <= MISC_OFF, "lds map");

#define RLX_AGENT __ATOMIC_RELAXED, __HIP_MEMORY_SCOPE_AGENT
#define LDS_WAIT() asm volatile("s_waitcnt lgkmcnt(0)" ::: "memory")
#define VM_WAIT() asm volatile("s_waitcnt vmcnt(0)" ::: "memory")
__device__ __forceinline__ unsigned pkbf(float lo, float hi) { typedef float f2 __attribute__((ext_vector_type(2))); typedef __bf16 b2 __attribute__((ext_vector_type(2))); f2 v = {lo, hi}; b2 b = __builtin_convertvector(v, b2); return __builtin_bit_cast(unsigned, b); }
__device__ __forceinline__ void st16_wt(const __amdgpu_buffer_rsrc_t r, unsigned off, u32x4 v) { __builtin_amdgcn_raw_buffer_store_b128(v, r, off, 0,   16); }
__device__ __forceinline__ float fexp(float x) { return __builtin_amdgcn_exp2f(x * 1.4426950408889634f); }
__device__ __forceinline__ float flog(float x) { return __builtin_amdgcn_logf(x) * 0.6931471805599453f; }
__device__ __forceinline__ float dot4(f32x4 a) { return (a.x * a.x + a.y * a.y) + (a.z * a.z + a.w * a.w); }
__device__ __forceinline__ float row_rscale(const float* ssq, int row) {
    const f32x4 a = *(const f32x4*)(ssq + (size_t)row * 8), b = *(const f32x4*)(ssq + (size_t)row * 8 + 4);
    return __builtin_amdgcn_rsqf(((a.x + a.y) + (a.z + a.w) + (b.x + b.y) + (b.z + b.w)) * (1.0f / DM) + EPS);
}
#define EPI_BAR() do { asm volatile("s_waitcnt lgkmcnt(0)" ::: "memory"); __builtin_amdgcn_s_barrier(); asm volatile("" ::: "memory"); } while (0)

typedef pg8::f32x4 acc_t[2][2][4][2];

struct EpiSwiGLU {
    static constexpr bool PERM = true, AFTER_DRAIN = false, ADJ = false, PREFETCH = true;
    bf16* H; const float* ssq; LAS float* tabs;
    __device__ __forceinline__ void prefetch(const pg8::Unit& u, LAS unsigned char* lds, int tid, int wid) const {
        __builtin_amdgcn_global_load_lds((const unsigned*)(ssq + (size_t)(u.pm * 256) * 8 + tid * 4), (LAS unsigned*)(lds + TAB2_OFF + wid * 1024), 16, 0, 0);
    }
    __device__ __forceinline__ void operator()(const acc_t& acc, const pg8::Unit& u, int wr, int wc, int fr, int fq) const {
        const int row0 = u.pm * 256 + wr * 64 + fr, col0 = u.pn * 128 + wc * 32 + 8 * fq;
        const __amdgpu_buffer_rsrc_t hr = __builtin_amdgcn_make_buffer_rsrc((void*)H, 0, (int)((size_t)MR * DFF * 2), 0x00020000);
        f32x4 pa[2][4], pb[2][4]; float rs[2][4];
#pragma unroll
        for (int ai = 0; ai < 2; ++ai)
#pragma unroll
            for (int m = 0; m < 4; ++m) { const LAS float* sp = tabs + (wr * 64 + fr + ai * 128 + m * 16) * 8; pa[ai][m] = *(const LAS f32x4*)sp; pb[ai][m] = *(const LAS f32x4*)(sp + 4); }
#pragma unroll
        for (int ai = 0; ai < 2; ++ai)
#pragma unroll
            for (int m = 0; m < 4; ++m) { const f32x4 a4 = pa[ai][m], b4 = pb[ai][m]; rs[ai][m] = __builtin_amdgcn_rsqf(((a4.x + a4.y) + (a4.z + a4.w) + (b4.x + b4.y) + (b4.z + b4.w)) * (1.0f / DM) + EPS); }
#pragma unroll
        for (int ai = 0; ai < 2; ++ai)
#pragma unroll
            for (int m = 0; m < 4; ++m) {
                const int row = row0 + ai * 128 + m * 16; const float r = rs[ai][m];
                float hv[8];
#pragma unroll
                for (int n = 0; n < 2; ++n)
#pragma unroll
                    for (int e = 0; e < 4; ++e) { const float a = acc[ai][0][m][n][e] * r, b = acc[ai][1][m][n][e] * r;
                        hv[n * 4 + e] = a * __builtin_amdgcn_rcpf(1.0f + fexp(-a)) * b; }
                u32x4 w; w.x = pkbf(hv[0], hv[1]); w.y = pkbf(hv[2], hv[3]); w.z = pkbf(hv[4], hv[5]); w.w = pkbf(hv[6], hv[7]);
                st16_wt(hr, (unsigned)((size_t)(row - fr) * DFF * 2 + (size_t)(fr & 7) * (2 * DFF * 2) + (u.pn * 4 + wc) * 128 + (fr >> 3) * 64 + fq * 16), w);
            }
    }
};

struct EpiResid {
    static constexpr bool PERM = true, AFTER_DRAIN = false, ADJ = true, PREFETCH = false;
    bf16* xb; float* outf; float* ssq_out; LAS float* tab;
    __device__ __forceinline__ void operator()(const acc_t& acc, const pg8::Unit& u, int wr, int wc, int fr, int fq) const {
        const int rl0 = wr * 64 + fr, row0 = u.pm * 256 + rl0, col0 = u.pn * 256 + wc * 64 + 8 * fq;
        const __amdgpu_buffer_rsrc_t xr = __builtin_amdgcn_make_buffer_rsrc((void*)xb, 0, (int)((size_t)MR * DM * 2), 0x00020000);
        const bool lower = fr < 8;
        const size_t lbase = ((size_t)(u.pm * 256 + wr * 64 + (fr & 7)) * DM + u.pn * 256) * 2 + (size_t)(wc * 128 + (lower ? 0 : 64) + fq * 16);
        u32x4 xpre[2][4][2];
#pragma unroll
        for (int ai = 0; ai < 2; ++ai)
#pragma unroll
            for (int m = 0; m < 4; ++m)
#pragma unroll
                for (int bj = 0; bj < 2; ++bj) xpre[ai][m][bj] = *(const u32x4*)((const char*)xb + lbase + (size_t)((ai * 128 + m * 16 + 8 * bj) * DM * 2));
        asm volatile("" : "+v"(xpre[0][0][0]), "+v"(xpre[0][1][0]), "+v"(xpre[0][2][0]), "+v"(xpre[0][3][0]), "+v"(xpre[1][0][0]), "+v"(xpre[1][1][0]), "+v"(xpre[1][2][0]), "+v"(xpre[1][3][0]) :: "memory");
        asm volatile("" : "+v"(xpre[0][0][1]), "+v"(xpre[0][1][1]), "+v"(xpre[0][2][1]), "+v"(xpre[0][3][1]), "+v"(xpre[1][0][1]), "+v"(xpre[1][1][1]), "+v"(xpre[1][2][1]), "+v"(xpre[1][3][1]) :: "memory");
        const unsigned sbase = (unsigned)lbase;
#pragma unroll
        for (int ai = 0; ai < 2; ++ai)
#pragma unroll
            for (int m = 0; m < 4; ++m) {
                const int row = row0 + ai * 128 + m * 16; float sq = 0.f;
                u32x4 w[2], xo[2];
                {
                    const u32x4 la = xpre[ai][m][0], lb = xpre[ai][m][1]; u32x4 ls, lr;
                    ls.x = lower ? lb.x : la.x; ls.y = lower ? lb.y : la.y; ls.z = lower ? lb.z : la.z; ls.w = lower ? lb.w : la.w;
                    lr.x = (unsigned)__builtin_amdgcn_mov_dpp((int)ls.x, 0x128, 0xf, 0xf, false); lr.y = (unsigned)__builtin_amdgcn_mov_dpp((int)ls.y, 0x128, 0xf, 0xf, false);
                    lr.z = (unsigned)__builtin_amdgcn_mov_dpp((int)ls.z, 0x128, 0xf, 0xf, false); lr.w = (unsigned)__builtin_amdgcn_mov_dpp((int)ls.w, 0x128, 0xf, 0xf, false);
                    xo[0].x = lower ? la.x : lr.x; xo[0].y = lower ? la.y : lr.y; xo[0].z = lower ? la.z : lr.z; xo[0].w = lower ? la.w : lr.w;
                    xo[1].x = lower ? lr.x : lb.x; xo[1].y = lower ? lr.y : lb.y; xo[1].z = lower ? lr.z : lb.z; xo[1].w = lower ? lr.w : lb.w;
                }
#pragma unroll
                for (int bj = 0; bj < 2; ++bj) {
                    const size_t o = (size_t)row * DM + col0 + bj * 32;
                    const u32x4 xin = xo[bj];
                    f32x4 x0, x1;
                    x0.x = __uint_as_float(xin.x << 16); x0.y = __uint_as_float(xin.x & 0xffff0000u); x0.z = __uint_as_float(xin.y << 16); x0.w = __uint_as_float(xin.y & 0xffff0000u);
                    x1.x = __uint_as_float(xin.z << 16); x1.y = __uint_as_float(xin.z & 0xffff0000u); x1.z = __uint_as_float(xin.w << 16); x1.w = __uint_as_float(xin.w & 0xffff0000u);
                    const f32x4 v0 = x0 + acc[ai][bj][m][0], v1 = x1 + acc[ai][bj][m][1];
                    if (outf) { *(f32x4*)(outf + o) = v0; *(f32x4*)(outf + o + 4) = v1; }
                    w[bj].x = pkbf(v0.x, v0.y); w[bj].y = pkbf(v0.z, v0.w); w[bj].z = pkbf(v1.x, v1.y); w[bj].w = pkbf(v1.z, v1.w);
                    sq += dot4(v0) + dot4(v1);
                }
                if (outf) continue;
                u32x4 xs, yr;
                xs.x = lower ? w[1].x : w[0].x; xs.y = lower ? w[1].y : w[0].y; xs.z = lower ? w[1].z : w[0].z; xs.w = lower ? w[1].w : w[0].w;
                yr.x = (unsigned)__builtin_amdgcn_mov_dpp((int)xs.x, 0x128, 0xf, 0xf, false); yr.y = (unsigned)__builtin_amdgcn_mov_dpp((int)xs.y, 0x128, 0xf, 0xf, false);
                yr.z = (unsigned)__builtin_amdgcn_mov_dpp((int)xs.z, 0x128, 0xf, 0xf, false); yr.w = (unsigned)__builtin_amdgcn_mov_dpp((int)xs.w, 0x128, 0xf, 0xf, false);
                u32x4 dA, dB;
                dA.x = lower ? w[0].x : yr.x; dA.y = lower ? w[0].y : yr.y; dA.z = lower ? w[0].z : yr.z; dA.w = lower ? w[0].w : yr.w;
                dB.x = lower ? yr.x : w[1].x; dB.y = lower ? yr.y : w[1].y; dB.z = lower ? yr.z : w[1].z; dB.w = lower ? yr.w : w[1].w;
                const unsigned so = sbase + (unsigned)((ai * 128 + m * 16) * DM * 2);
                st16_wt(xr, so, dA); st16_wt(xr, so + (unsigned)(8 * DM * 2), dB);
                sq += __shfl_xor(sq, 16); sq += __shfl_xor(sq, 32);
                if (fq == 0) tab[(rl0 + ai * 128 + m * 16) * 4 + wc] = sq;
            }
        if (outf) return;
        EPI_BAR();
#pragma unroll
        for (int t = 0; t < 2; ++t) { const int g = wc * 2 + t, rl = (g >> 2) * 128 + (g & 3) * 16 + rl0;
            if (fq == 0) { const f32x4 p = *(const LAS f32x4*)(tab + rl * 4); __hip_atomic_store(ssq_out + (size_t)(u.pm * 256 + rl) * 8 + u.pn, (p.x + p.y) + (p.z + p.w), RLX_AGENT); } }
    }
};

struct EpiQKV {
    static constexpr bool PERM = true, AFTER_DRAIN = false, ADJ = false, PREFETCH = true;
    bf16* QKV; bf16* MKV; const float* ssq; const float* gains;
    float* out; int l;
    LAS float* tab2; LAS float* tabs;
    __device__ __forceinline__ void prefetch(const pg8::Unit& u, LAS unsigned char* lds, int tid, int wid) const {
        const int r0 = u.pm >= MR / 256 ? 0 : u.pm * 256;
        __builtin_amdgcn_global_load_lds((const unsigned*)(ssq + (size_t)r0 * 8 + tid * 4), (LAS unsigned*)(lds + TAB3_OFF + wid * 1024), 16, 0, 0);
    }
    __device__ __forceinline__ void operator()(const acc_t& acc, const pg8::Unit& u, int wr, int wc, int fr, int fq) const {
        const int pm = u.pm, pn = u.pn; const bool memrow = pm >= MR / 256; const int layerB = l & 1, j = l >> 1;
        const int rl0 = wr * 64 + fr, row0 = pm * 256 + rl0, cw = wc * 32 + 8 * fq;
        const int kind = memrow ? (pn < 16 ? 4 : 5) : (pn < 4 ? 0 : pn < 8 ? 1 : pn < 12 ? 2 : 3);
        const bool need_norm = (kind == 3) || (kind == 4) || (!layerB && kind <= 1);
        acc_t& va = const_cast<acc_t&>(acc);
#define VQ(ai, bj, m, e) va[ai][bj][m][(e) >> 2][(e) & 3]
        int zo = 0;
        f32x4 pa[2][4], pb[2][4];
#pragma unroll
        for (int ai = 0; ai < 2; ++ai)
#pragma unroll
            for (int m = 0; m < 4; ++m) { const LAS float* sp = tabs + (rl0 + ai * 128 + m * 16) * 8; pa[ai][m] = *(const LAS f32x4*)sp; pb[ai][m] = *(const LAS f32x4*)(sp + 4); }
        float sq[2][4][2];
#pragma unroll
        for (int ai = 0; ai < 2; ++ai)
#pragma unroll
            for (int m = 0; m < 4; ++m) {
                const f32x4 a4 = pa[ai][m], b4 = pb[ai][m];
                float r = __builtin_amdgcn_rsqf(((a4.x + a4.y) + (a4.z + a4.w) + (b4.x + b4.y) + (b4.z + b4.w)) * (1.0f / DM) + EPS);
                r = memrow ? 1.0f : r;
#pragma unroll
                for (int bj = 0; bj < 2; ++bj) {
#pragma unroll
                    for (int n = 0; n < 2; ++n) va[ai][bj][m][n] *= r;
                    sq[ai][m][bj] = dot4(va[ai][bj][m][0]) + dot4(va[ai][bj][m][1]);
                }
            }
        if (need_norm) {
#pragma unroll
            for (int ai = 0; ai < 2; ++ai)
#pragma unroll
                for (int m = 0; m < 4; ++m)
#pragma unroll
                    for (int bj = 0; bj < 2; ++bj) sq[ai][m][bj] += __shfl_xor(sq[ai][m][bj], 16);
#pragma unroll
            for (int ai = 0; ai < 2; ++ai)
#pragma unroll
                for (int m = 0; m < 4; ++m)
#pragma unroll
                    for (int bj = 0; bj < 2; ++bj) sq[ai][m][bj] += __shfl_xor(sq[ai][m][bj], 32);
            if (fq == 0) {
#pragma unroll
                for (int ai = 0; ai < 2; ++ai)
#pragma unroll
                    for (int m = 0; m < 4; ++m)
#pragma unroll
                        for (int bj = 0; bj < 2; ++bj) tab2[((rl0 + ai * 128 + m * 16) * 2 + bj) * 4 + wc] = sq[ai][m][bj];
            }
        }
        float g[8];
        if (need_norm) {
            EPI_BAR();
            const float* gp = gains + ((kind == 0) ? 0 : (kind == 1) ? 128 : (kind == 3) ? 256 : 384);
            const float post = (kind == 0 || kind == 3) ? 0.08838834764831845f : 1.0f;
#pragma unroll
            for (int e = 0; e < 8; ++e) g[e] = gp[cw + e] * post;
        } else {
            const float post = (kind == 0) ? 0.0625f : 1.0f;
#pragma unroll
            for (int e = 0; e < 8; ++e) g[e] = post;
        }
        float* fo = nullptr; int fpitch = TOKW;
        const int ct = (kind == 1) ? (pn - 4) * 256 : (kind == 2) ? (pn - 8) * 256 : (kind == 4) ? (pn - 14) * 256 : (kind == 5) ? (pn - 16) * 256 : 0;
        if (kind == 1 || kind == 2) {
            const bool isk = kind == 1;
            if (pm >= NP / 256) fo = out + (layerB ? (isk ? O_BKS : O_BVS) : (isk ? O_AKS : O_AVS)) + (size_t)j * NS * TOKW + (size_t)(pm * 256 - NP) * TOKW;
            else if (layerB) fo = out + (isk ? O_BKP : O_BVP) + (size_t)j * NP * TOKW + (size_t)(pm * 256) * TOKW;
            else if ((pm & 63) >= 62) fo = out + (isk ? O_AKP : O_AVP) + (size_t)j * NB * 512 * TOKW + (size_t)((pm >> 6) * 512 + ((pm & 63) - 62) * 256) * TOKW;
        } else if (kind >= 4) { fo = out + (kind == 4 ? O_MKP : O_MVP) + (size_t)l * NMR * MEMW + (size_t)(pm * 256 - MR) * MEMW; fpitch = MEMW; }
        if (fo) fo += ct + cw;
        bf16* bo = memrow ? MKV + (size_t)(pm * 256 - MR) * 1024 + (pn - 14) * 256 + cw : QKV + (size_t)(pm * 256) * QKVW + pn * 256 + cw;
        const int bpitch = memrow ? 1024 : QKVW;
        const __amdgpu_buffer_rsrc_t br = __builtin_amdgcn_make_buffer_rsrc((void*)(memrow ? MKV : QKV), 0, memrow ? (int)((size_t)NMR * 1024 * 2) : (int)((size_t)MR * QKVW * 2), 0x00020000);
        const unsigned bo0 = (unsigned)((const char*)bo - (const char*)(memrow ? MKV : QKV));
#pragma unroll
        for (int ai = 0; ai < 2; ++ai)
#pragma unroll
            for (int m = 0; m < 4; ++m) {
                asm volatile("" : "+s"(zo) :: "memory");
                const int rl = rl0 + ai * 128 + m * 16 + zo;
#pragma unroll
                for (int bj = 0; bj < 2; ++bj) {
                    float rn = 1.0f;
                    if (need_norm) { const f32x4 p = *(const LAS f32x4*)(tab2 + (rl * 2 + bj) * 4); rn = __builtin_amdgcn_rsqf(((p.x + p.y) + (p.z + p.w)) * (1.0f / 128.0f) + EPS); }
#pragma unroll
                    for (int e = 0; e < 8; ++e) VQ(ai, bj, m, e) *= rn * g[e];
                    const f32x4 x0 = va[ai][bj][m][0], x1 = va[ai][bj][m][1];
                    u32x4 w; w.x = pkbf(x0.x, x0.y); w.y = pkbf(x0.z, x0.w); w.z = pkbf(x1.x, x1.y); w.w = pkbf(x1.z, x1.w);
                    st16_wt(br, bo0 + (unsigned)((rl * bpitch + bj * 128) * 2), w);
                    if (fo) { float* p = fo + (size_t)rl * fpitch + bj * 128; *(f32x4*)p = x0; *(f32x4*)(p + 4) = x1; }
                }
            }
    }
};
#undef VQ
__device__ __forceinline__ void unit_map(int L, int nM, int nN, pg8::Unit& u) {
    const int nwg = nM * nN; int wgid = L; { const int q = nwg / 8, r = nwg % 8, xcd = wgid % 8, off = wgid / 8; wgid = (xcd < r ? xcd * (q + 1) : r * (q + 1) + (xcd - r) * q) + off; }
    const int nig = 8 * nN, gid = wgid / nig, fm = gid * 8, gsz = (nM - fm) < 8 ? (nM - fm) : 8;
    u.pm = fm + ((wgid % nig) % gsz); u.pn = (wgid % nig) / gsz;
}
struct XcdDeal {
    int nN, x, r, k0, n, lbase;
    __device__ __forceinline__ void init(int nN_, int T, int c, int& base) { nN = nN_; x = c & 7; r = c >> 3; n = 16 * nN_ + (T - x + 7) / 8; const int d = base - r; k0 = d > 0 ? (d + 31) >> 5 : 0; lbase = base; base += n; }
    __device__ __forceinline__ bool next(int i, pg8::Unit& u) const {
        const int loc = r + 32 * (k0 + i) - lbase; if (loc >= n) return false;
        if (loc < 16 * nN) { const int g8 = loc >= 8 * nN, w = loc - g8 * 8 * nN; u.pm = x + 8 * (g8 * 8 + (w & 7)); u.pn = w >> 3; return true; }
        const int t = (loc - 16 * nN) * 8 + x;
        if (t < 2 * nN) { u.pm = NP / 256 + (t & 1); u.pn = t >> 1; } else { const int m = t - 2 * nN; u.pm = MR / 256 + (m >> 2); u.pn = 14 + (m & 3); }
        return true;
    }
    __device__ __forceinline__ void a_ready(const pg8::Unit&) const {}
    __device__ __forceinline__ void done(const pg8::Unit&) const {}
};
struct DynDeal {
    int nN, T, x, w0; unsigned* ctr; mutable int par;
    __device__ __forceinline__ bool next(int, pg8::Unit& u) const {
        volatile LAS unsigned* slot = (volatile LAS unsigned*)(unsigned)(MISC_OFF + 104);
        if (w0) {
            if (__builtin_amdgcn_mbcnt_hi(~0u, __builtin_amdgcn_mbcnt_lo(~0u, 0u)) == 0u) {
                unsigned code = 0u;
                for (int v = 0; v < 8; ++v) {
                    const int xv = (x + v) & 7; const unsigned nv = 16u * nN + (unsigned)(T - xv + 7) / 8u;
                    const unsigned e = __hip_atomic_fetch_add(ctr + 16 * xv, 1u, RLX_AGENT);
                    if (e < nv) { code = (((unsigned)xv << 16) | e) + 1u; break; }
                }
                slot[par] = code;
            }
            asm volatile("s_waitcnt lgkmcnt(0)" ::: "memory");
        }
        asm volatile("" ::: "memory"); __builtin_amdgcn_s_barrier(); asm volatile("" ::: "memory");
        const unsigned code = (unsigned)__builtin_amdgcn_readfirstlane(slot[par]); par ^= 1;
        if (code == 0u) return false;
        const int xv = (int)((code - 1u) >> 16), loc = (int)((code - 1u) & 0xffffu);
        if (loc < 16 * nN) { const int g8 = loc >= 8 * nN, w = loc - g8 * 8 * nN; u.pm = xv + 8 * (g8 * 8 + (w & 7)); u.pn = w >> 3; return true; }
        const int t = (loc - 16 * nN) * 8 + xv;
        if (t < 2 * nN) { u.pm = NP / 256 + (t & 1); u.pn = t >> 1; } else { const int m = t - 2 * nN; u.pm = MR / 256 + (m >> 2); u.pn = 14 + (m & 3); }
        return true;
    }
    __device__ __forceinline__ void a_ready(const pg8::Unit&) const {}
    __device__ __forceinline__ void done(const pg8::Unit&) const {}
};
constexpr int PC_WORD0 = 131072, PC_STRIDE = 16, DC_WORD0 = 180224, BC_WORD0 = 184320;
struct Gate { const unsigned* wctr; unsigned need; unsigned* pctr; unsigned* tmo; int w0; int bmode = 0; };
template <class Base> struct Gated : Base {
    Gate g; mutable int rdy;
    __device__ __forceinline__ void a_ready(const pg8::Unit& u) const {
        if (g.wctr == nullptr || u.pm == rdy || u.pm >= MR / 256) return;
        rdy = u.pm;
        if (g.w0) {
            const unsigned* p = g.wctr + PC_STRIDE * u.pm;
            unsigned polls = 0;
            while ((unsigned)__builtin_amdgcn_readfirstlane(__hip_atomic_load(p, RLX_AGENT)) < g.need) {
                if ((++polls & 255u) == 0u) {
                    if (__builtin_amdgcn_readfirstlane(__hip_atomic_load(g.tmo, RLX_AGENT)) != 0u) break;
                    if (polls > (1u << 18)) { __hip_atomic_store(g.tmo, 1u, RLX_AGENT); break; }
                }
                __builtin_amdgcn_s_sleep(2);
            }
            __builtin_amdgcn_fence(__ATOMIC_ACQUIRE, "agent");
            asm volatile("s_waitcnt vmcnt(0)" ::: "memory");
        }
        asm volatile("" ::: "memory"); __builtin_amdgcn_s_barrier(); asm volatile("" ::: "memory");
    }
    __device__ __forceinline__ void done(const pg8::Unit& u) const {
        if (g.pctr == nullptr) return;
        asm volatile("s_waitcnt vmcnt(0)" ::: "memory");
        if (__builtin_amdgcn_mbcnt_hi(~0u, __builtin_amdgcn_mbcnt_lo(~0u, 0u)) == 0u) __hip_atomic_fetch_add(g.pctr + PC_STRIDE * (g.bmode ? (u.pm < 64 ? 0 : u.pm < 128 ? 1 : u.pm < MR / 256 ? 2 : 3) : u.pm), 1u, RLX_AGENT);
    }
};
#define XB_TMO      128
#define XB_XCNT(j)  (256  + 64 * (j))
#define XB_XSUB(j)  (1280 + 64 * (j))
#define XB_XGEN(j)  (2304 + 64 * (j))
#define XB_TOP      3328
#define XB_TOPGEN   3392
#define XCD_BAR_WORDS 3456
#define XB_SPIN_CAP (1u << 18)

__device__ __forceinline__ unsigned xb_ld(unsigned* p)              { return __hip_atomic_load(p, __ATOMIC_RELAXED, __HIP_MEMORY_SCOPE_AGENT); }
__device__ __forceinline__ unsigned xb_add(unsigned* p, unsigned v) { return __hip_atomic_fetch_add(p, v, __ATOMIC_RELAXED, __HIP_MEMORY_SCOPE_AGENT); }
__device__ __forceinline__ unsigned xb_xcc_id() { return (unsigned)__builtin_amdgcn_s_getreg((3 << 11) | 20) & 0xFu; }
#define XB_SPIN(cond, bar) do { unsigned _sp = 0; while (cond) { __builtin_amdgcn_s_sleep(1); \
    if ((++_sp & 255u) == 0u) { if (xb_ld(&(bar)[XB_TMO])) break; if (_sp > XB_SPIN_CAP) { atomicAdd(&(bar)[XB_TMO], 1u); break; } } } } while (0)

struct XcdBarrier {
    unsigned total;
    unsigned* bar; unsigned x;
    volatile LAS unsigned* st;
};

__device__ __forceinline__ XcdBarrier xcd_barrier_post(unsigned* bar, volatile LAS unsigned* st) {
    XcdBarrier b; b.total = 0u; b.bar = bar; b.x = xb_xcc_id(); b.st = st;
    if (threadIdx.x == 0) (void)xb_add(&bar[XB_XCNT(b.x)], 1u);
    return b;
}
__device__ __forceinline__ void xcd_barrier_complete(unsigned* bar, unsigned x, unsigned& nloc, unsigned& nx, unsigned total) {
    const unsigned G = total ? total : gridDim.x * gridDim.y * gridDim.z;
    unsigned sum, cnt, mine, sp = 0u;
    for (;;) {
        sum = 0u; cnt = 0u; mine = 0u;
#pragma unroll
        for (unsigned j = 0; j < 16; ++j) { const unsigned c = xb_ld(&bar[XB_XCNT(j)]); sum += c; cnt += (c > 0u) ? 1u : 0u; mine = (j == x) ? c : mine; }
        if (sum == G) break;
        __builtin_amdgcn_s_sleep(1);
        if ((++sp & 255u) == 0u) { if (xb_ld(&bar[XB_TMO])) break; if (sp > XB_SPIN_CAP) { atomicAdd(&bar[XB_TMO], 1u); break; } }
    }
    nloc = mine > 0u ? mine : 1u; nx = cnt > 0u ? cnt : 1u;
}

__device__ __forceinline__ void xcd_barrier(const XcdBarrier& b) {
    asm volatile("s_waitcnt vmcnt(0)" ::: "memory");
    __syncthreads();
    if (threadIdx.x == 0) {
        unsigned* bar = b.bar;
        __builtin_amdgcn_s_waitcnt(0);
        unsigned nloc = b.st[0], nx = b.st[1];
        if (nloc == 0u) { xcd_barrier_complete(bar, b.x, nloc, nx, b.total); b.st[0] = nloc; b.st[1] = nx; }
        const unsigned old = xb_add(&bar[XB_XSUB(b.x)], 1u);
        const unsigned gen = old / nloc;
        if (old + 1u == (gen + 1u) * nloc) {
            __builtin_amdgcn_fence(__ATOMIC_RELEASE, "agent");
            asm volatile("s_waitcnt vmcnt(0)" ::: "memory");
            const unsigned og = xb_add(&bar[XB_TOP], 1u);
            const unsigned tg = og / nx;
            if (og + 1u == (tg + 1u) * nx) xb_add(&bar[XB_TOPGEN], 1u);
            else XB_SPIN(xb_ld(&bar[XB_TOPGEN]) == tg, bar);
            __builtin_amdgcn_fence(__ATOMIC_ACQUIRE, "agent");
            xb_add(&bar[XB_XGEN(b.x)], 1u);
            asm volatile("s_waitcnt vmcnt(0)" ::: "memory");
        } else {
            XB_SPIN(xb_ld(&bar[XB_XGEN(b.x)]) == gen, bar);
            __builtin_amdgcn_fence(__ATOMIC_ACQUIRE, "agent");
            asm volatile("s_waitcnt vmcnt(0)" ::: "memory");
        }
    }
    __syncthreads();
}


namespace att {
#define MFMA16(a, b, c) __builtin_amdgcn_mfma_f32_16x16x32_bf16((a), (b), (c), 0, 0, 0)
typedef short v4i16_t __attribute__((ext_vector_type(4)));
__device__ __forceinline__ s16x4 vtr(const LAS char* p) { return __builtin_bit_cast(s16x4, __builtin_amdgcn_ds_read_tr16_b64_v4i16((LAS v4i16_t*)p)); }

template <bool F32> __device__ __forceinline__ bf16x8 ld8(const char* rowp, int col) {
    if constexpr (F32) { const f32x4 a = *(const f32x4*)(rowp + (size_t)col * 4), b = *(const f32x4*)(rowp + (size_t)col * 4 + 16);
        u32x4 w; w.x = pkbf(a.x, a.y); w.y = pkbf(a.z, a.w); w.z = pkbf(b.x, b.y); w.w = pkbf(b.z, b.w); return __builtin_bit_cast(bf16x8, w); }
    else return *(const bf16x8*)(rowp + (size_t)col * 2);
}
template <int HD, int QB> __device__ __forceinline__ void load_q(bf16x8 (&qf)[QB][HD / 32], const bf16* q  , int fr, int fq) {
#pragma unroll
    for (int qb = 0; qb < QB; ++qb)
#pragma unroll
        for (int ks = 0; ks < HD / 32; ++ks) qf[qb][ks] = *(const bf16x8*)(q + (size_t)(16 * qb + fr) * QKVW + 32 * ks + 8 * fq);
}
template <int HD, int QB, bool F32> __device__ __forceinline__ void qk_tile(f32x4 (&s)[2][QB], const bf16x8 (&qf)[QB][HD / 32], const char* kbase, size_t pitchB, int key0, int kmax, int fr, int fq) {
#pragma unroll
    for (int u = 0; u < 2; ++u) {
        int row = key0 + 16 * u + fr; row = row < kmax ? row : kmax;
        const char* rp = kbase + (size_t)row * pitchB;
        bf16x8 kf[HD / 32];
#pragma unroll
        for (int ks = 0; ks < HD / 32; ++ks) kf[ks] = ld8<F32>(rp, 32 * ks + 8 * fq);
#pragma unroll
        for (int qb = 0; qb < QB; ++qb) { f32x4 a = {0.f, 0.f, 0.f, 0.f};
#pragma unroll
            for (int ks = 0; ks < HD / 32; ++ks) a = MFMA16(kf[ks], qf[qb][ks], a);
            s[u][qb] = a; }
    }
}
template <int HD, bool F32> __device__ __forceinline__ void stage_v(LAS char* vt, const char* vbase, size_t pitchB, int key0, int kmax, int lane) {
    constexpr int CPR = HD / 8, PITCH = HD * 2 + 32;
#pragma unroll
    for (int i = 0; i < 32 * CPR / 64; ++i) { const int n = lane + 64 * i, row = n / CPR, ch = n % CPR; int grow = key0 + row; grow = grow < kmax ? grow : kmax;
        const bf16x8 v = ld8<F32>(vbase + (size_t)grow * pitchB, ch * 8);
        *(LAS bf16x8*)(vt + row * PITCH + ch * 16) = v; }
}
template <int HD, int QB, int PITCH = HD * 2 + 32> __device__ __forceinline__ void pv_tile(f32x4 (&o)[HD / 16][QB], const bf16x8 (&pf)[QB], const LAS char* vt, int lane) {
    const int fq = lane >> 4, q = (lane & 15) >> 2, p = lane & 3;
    const LAS char* base = vt + (4 * fq + q) * PITCH + p * 8;
#pragma unroll
    for (int c = 0; c < HD / 16; ++c) {
        const s16x4 lo = vtr(base + c * 32), hi = vtr(base + 16 * PITCH + c * 32);
        const bf16x8 vf = __builtin_shufflevector(lo, hi, 0, 1, 2, 3, 4, 5, 6, 7);
#pragma unroll
        for (int qb = 0; qb < QB; ++qb) o[c][qb] = MFMA16(vf, pf[qb], o[c][qb]);
    }
}
__device__ __forceinline__ bf16x8 pack8(const f32x4& a, const f32x4& b) { u32x4 w; w.x = pkbf(a.x, a.y); w.y = pkbf(a.z, a.w); w.z = pkbf(b.x, b.y); w.w = pkbf(b.z, b.w); return __builtin_bit_cast(bf16x8, w); }

template <int HD, int QB> __device__ __forceinline__ void softmax_step(f32x4 (&s)[2][QB], const unsigned (&vmask)[QB], float (&m)[QB], float (&l)[QB], f32x4 (&o)[HD / 16][QB], bf16x8 (&pf)[QB]) {
#pragma unroll
    for (int qb = 0; qb < QB; ++qb) {
        float mx = -1e30f;
#pragma unroll
        for (int u = 0; u < 2; ++u)
#pragma unroll
            for (int i = 0; i < 4; ++i) { const bool ok = (vmask[qb] >> (4 * u + i)) & 1u; s[u][qb][i] = ok ? s[u][qb][i] : -1e30f; mx = fmaxf(mx, s[u][qb][i]); }
        mx = fmaxf(mx, __shfl_xor(mx, 16)); mx = fmaxf(mx, __shfl_xor(mx, 32));
        if (!__all(mx - m[qb] <= 8.0f)) {
            const float mn = fmaxf(m[qb], mx), alpha = fexp(m[qb] - mn);
            l[qb] *= alpha; m[qb] = mn;
#pragma unroll
            for (int c = 0; c < HD / 16; ++c) o[c][qb] *= alpha;
        }
        const float ml = m[qb] * 1.4426950408889634f;
        float ps = 0.f;
#pragma unroll
        for (int u = 0; u < 2; ++u)
#pragma unroll
            for (int i = 0; i < 4; ++i) { const bool ok = (vmask[qb] >> (4 * u + i)) & 1u; const float p = ok ? __builtin_amdgcn_exp2f(__builtin_fmaf(s[u][qb][i], 1.4426950408889634f, -ml)) : 0.f; s[u][qb][i] = p; ps += p; }
        l[qb] += ps;
        pf[qb] = pack8(s[0][qb], s[1][qb]);
    }
}
__device__ __forceinline__ void stick_step(f32x4 (&s)[2][1], unsigned vmask, float& R, bf16x8& pf, int fq) {
    float sp[2][4], suf[2][4], tot[2], later[2];
#pragma unroll
    for (int u = 0; u < 2; ++u) {
#pragma unroll
        for (int i = 0; i < 4; ++i) { const bool ok = (vmask >> (4 * u + i)) & 1u; const float z = s[u][0][i];
            sp[u][i] = ok ? (fmaxf(z, 0.f) + flog(1.0f + fexp(-fabsf(z)))) : 0.f; }
        suf[u][3] = sp[u][3]; suf[u][2] = sp[u][2] + suf[u][3]; suf[u][1] = sp[u][1] + suf[u][2]; suf[u][0] = sp[u][0] + suf[u][1];
        const float T = suf[u][0], t1 = __shfl_xor(T, 16), t2 = __shfl_xor(T, 32), t3 = __shfl_xor(T, 48);
        later[u] = ((fq ^ 1) > fq ? t1 : 0.f) + ((fq ^ 2) > fq ? t2 : 0.f) + ((fq ^ 3) > fq ? t3 : 0.f);
        tot[u] = (T + t1) + (t2 + t3);
    }
    f32x4 w[2];
#pragma unroll
    for (int i = 0; i < 4; ++i) {
        const bool ok1 = (vmask >> (4 + i)) & 1u, ok0 = (vmask >> i) & 1u;
        w[1][i] = ok1 ? fexp(s[1][0][i] - (R + later[1] + suf[1][i])) : 0.f;
        w[0][i] = ok0 ? fexp(s[0][0][i] - (R + tot[1] + later[0] + suf[0][i])) : 0.f;
    }
    R += tot[0] + tot[1];
    pf = pack8(w[0], w[1]);
}
template <int HD, int QB> __device__ __forceinline__ void store_o(const f32x4 (&o)[HD / 16][QB], const float (&inv)[QB], bf16* ao  , int nq, int fr, int fq) {
    asm volatile("" : "+v"(fr), "+v"(fq));
#pragma unroll
    for (int qb = 0; qb < QB; ++qb)
#pragma unroll
        for (int c = 0; c < HD / 16; c += 2) {
            const f32x4 xa = o[c][qb] * inv[qb], xb = o[c + 1][qb] * inv[qb];
            unsigned a0 = pkbf(xa.x, xa.y), a1 = pkbf(xa.z, xa.w), b0 = pkbf(xb.x, xb.y), b1 = pkbf(xb.z, xb.w);
            { auto r = __builtin_amdgcn_permlane16_swap(a0, b0, false, false); a0 = r[0]; b0 = r[1]; }
            { auto r = __builtin_amdgcn_permlane16_swap(a1, b1, false, false); a1 = r[0]; b1 = r[1]; }
            u32x4 w; w.x = a0; w.y = a1; w.z = b0; w.w = b1;
            if (16 * qb + fr < nq) *(u32x4*)(ao + (size_t)(16 * qb + fr) * AOW + 16 * (c + (fq & 1)) + 8 * (fq >> 1)) = w; }
}

template <int QB> __device__ __forceinline__ void bias_and_mask(f32x4 (&s)[2][QB], unsigned (&vmask)[QB], const float* relb, int qpos0, int key0, int nvalid, int kpos, int fr, int fq) {
#pragma unroll
    for (int qb = 0; qb < QB; ++qb) { unsigned vm = 0u;
#pragma unroll
        for (int u = 0; u < 2; ++u)
#pragma unroll
            for (int i = 0; i < 4; ++i) { const int kk = key0 + 16 * u + 4 * fq + i; if (kk < nvalid) vm |= 1u << (4 * u + i);
                if (relb) { int rel = (qpos0 + 16 * qb + fr) - (kpos + kk); rel = rel < -128 ? -128 : (rel > 128 ? 128 : rel); s[u][qb][i] += relb[rel + 128]; } }
        vmask[qb] = vm; }
}
template <int QB, bool SEG1, int NSPLIT>
__device__ __forceinline__ void softmax_item(const bf16* q, int qpos0, bf16* ao,
                                             const char* k1, const char* v1, size_t pitch1, int k1lo, int k1hi, int n1, int kpos1,
                                             const char* k2, const char* v2, size_t pitch2, int k2lo, int k2hi, int n2, int kpos2,
                                             const float* relb, LAS char* lds0, int wave, int lane) {
    constexpr int HD = 128;
    const int fr = lane & 15, fq = lane >> 4;
    LAS char* vt = lds0 + wave * VT_STRIDE;
    bf16x8 qf[QB][HD / 32]; load_q<HD, QB>(qf, q, fr, fq);
    f32x4 o[HD / 16][QB]; float m[QB], l[QB];
#pragma unroll
    for (int qb = 0; qb < QB; ++qb) { m[qb] = -1e30f; l[qb] = 0.f;
#pragma unroll
        for (int c = 0; c < HD / 16; ++c) o[c][qb] = (f32x4){0.f, 0.f, 0.f, 0.f}; }
    f32x4 s[2][QB]; bf16x8 pf[QB]; unsigned vmask[QB];
    if constexpr (SEG1) {
        for (int key0 = k1lo; key0 < k1hi; key0 += 32) {
            qk_tile<HD, QB, true>(s, qf, k1, pitch1, key0, n1 - 1, fr, fq);
            stage_v<HD, true>(vt, v1, pitch1, key0, n1 - 1, lane);
            bias_and_mask<QB>(s, vmask, relb, qpos0, key0, n1, kpos1, fr, fq);
            softmax_step<HD, QB>(s, vmask, m, l, o, pf);
            pv_tile<HD, QB>(o, pf, vt, lane);
        }
    }
    for (int key0 = k2lo; key0 < k2hi; key0 += 32) {
        qk_tile<HD, QB, false>(s, qf, k2, pitch2, key0, n2 - 1, fr, fq);
        stage_v<HD, false>(vt, v2, pitch2, key0, n2 - 1, lane);
        bias_and_mask<QB>(s, vmask, relb, qpos0, key0, n2, kpos2, fr, fq);
        softmax_step<HD, QB>(s, vmask, m, l, o, pf);
        pv_tile<HD, QB>(o, pf, vt, lane);
    }
#pragma unroll
    for (int qb = 0; qb < QB; ++qb) { float t = l[qb]; t += __shfl_xor(t, 16); t += __shfl_xor(t, 32); l[qb] = t; }
    if constexpr (NSPLIT > 1) {
        static_assert(QB == 1, "split items are 16-query items");
        LAS f32x4* po = (LAS f32x4*)(vt + 9216);
#pragma unroll
        for (int c = 0; c < HD / 16; ++c) po[c * 64 + lane] = o[c][0];
        { LAS float* ml = (LAS float*)(lds0 + 139264 + 512 * wave); ml[lane] = m[0]; ml[64 + lane] = l[0]; }
        __syncthreads();
        if ((wave % NSPLIT) == 0) {
            float mk[NSPLIT], lk[NSPLIT], M = -1e30f;
#pragma unroll
            for (int k = 0; k < NSPLIT; ++k) { const LAS float* ml = (const LAS float*)(lds0 + 139264 + 512 * (wave + k)); mk[k] = ml[lane]; lk[k] = ml[64 + lane]; M = fmaxf(M, mk[k]); }
            float L = 0.f;
#pragma unroll
            for (int k = 0; k < NSPLIT; ++k) { mk[k] = fexp(mk[k] - M); L += lk[k] * mk[k]; }
#pragma unroll
            for (int c = 0; c < HD / 16; ++c) { f32x4 a = {0.f, 0.f, 0.f, 0.f};
#pragma unroll
                for (int k = 0; k < NSPLIT; ++k) a += ((const LAS f32x4*)(lds0 + (wave + k) * VT_STRIDE + 9216))[c * 64 + lane] * mk[k];
                o[c][0] = a; }
            const float inv[1] = {1.0f / L};
            store_o<HD, 1>(o, inv, ao, 16, fr, fq);
        }
        __syncthreads();
    } else {
        float inv[QB];
#pragma unroll
        for (int qb = 0; qb < QB; ++qb) inv[qb] = 1.0f / l[qb];
        store_o<HD, QB>(o, inv, ao, 16 * QB, fr, fq);
    }
}

constexpr int BPITCH = 272, BK_BYTES = 64 * BPITCH;
template <int QB, int HD = 128, int PITCH = BPITCH> __device__ __forceinline__ void qk_tile_lds(f32x4 (&s)[2][QB], const bf16x8 (&qf)[QB][HD / 32], const LAS char* kt, int fr, int fq) {
#pragma unroll
    for (int u = 0; u < 2; ++u) {
        const LAS char* rp = kt + (16 * u + fr) * PITCH + 16 * fq;
        bf16x8 kf[HD / 32];
#pragma unroll
        for (int ks = 0; ks < HD / 32; ++ks) kf[ks] = *(const LAS bf16x8*)(rp + 64 * ks);
#pragma unroll
        for (int qb = 0; qb < QB; ++qb) { f32x4 a = {0.f, 0.f, 0.f, 0.f};
#pragma unroll
            for (int ks = 0; ks < HD / 32; ++ks) a = MFMA16(kf[ks], qf[qb][ks], a);
            s[u][qb] = a; }
    }
}
template <bool BAND>
__device__ __forceinline__ void softmax_block(const bf16* q  , bf16* ao, const char* kbase, const char* vbase, size_t pitchB,
                                              int kc_lo, int kc_hi  , int c0  , const float* relb, LAS char* lds, int tid) {
    constexpr int HD = 128, QB = 2;
    const int lane = tid & 63, wave = __builtin_amdgcn_readfirstlane(tid >> 6), fr = lane & 15, fq = lane >> 4;
    const int srow = tid >> 4, sch = tid & 15;
    bf16x8 pk[2], pw[2];
#define SB_ISSUE(kc) do { _Pragma("unroll") for (int i_ = 0; i_ < 2; ++i_) { const size_t go_ = (size_t)((kc) * 64 + srow + 32 * i_) * pitchB + sch * 16; \
        pk[i_] = *(const bf16x8*)(kbase + go_); pw[i_] = *(const bf16x8*)(vbase + go_); } } while (0)
#define SB_WRITE(buf) do { _Pragma("unroll") for (int i_ = 0; i_ < 2; ++i_) { const int lo_ = (srow + 32 * i_) * BPITCH + sch * 16; \
        *(LAS bf16x8*)(lds + (buf) * BK_BYTES + lo_) = pk[i_]; *(LAS bf16x8*)(lds + (2 + (buf)) * BK_BYTES + lo_) = pw[i_]; } } while (0)
    SB_ISSUE(kc_lo);
    LAS float* bt = (LAS float*)(lds + 4 * BK_BYTES);
    if (BAND) for (int i = tid; i < 257; i += 512) bt[i] = relb[i];
    bf16x8 qf[QB][4]; load_q<HD, QB>(qf, q + (size_t)(32 * wave) * QKVW, fr, fq);
    f32x4 o[HD / 16][QB]; float m[QB], l[QB];
#pragma unroll
    for (int qb = 0; qb < QB; ++qb) { m[qb] = -1e30f; l[qb] = 0.f;
#pragma unroll
        for (int c = 0; c < HD / 16; ++c) o[c][qb] = (f32x4){0.f, 0.f, 0.f, 0.f}; }
    SB_WRITE(0);
    __syncthreads();
    const int cw = c0 + (wave >> 1), qp0 = c0 * 64 + 32 * wave;
    const unsigned vall[QB] = {0xffu, 0xffu};
    for (int kc = kc_lo; kc < kc_hi; ++kc) {
        const int buf = (kc - kc_lo) & 1;
        if (kc + 1 < kc_hi) SB_ISSUE(kc + 1);
        if (!BAND || (kc >= cw - 8 && kc <= cw)) {
#pragma unroll
            for (int sub = 0; sub < 2; ++sub) {
                f32x4 s[2][QB]; bf16x8 pf[QB];
                qk_tile_lds<QB>(s, qf, lds + buf * BK_BYTES + sub * 32 * BPITCH, fr, fq);
                if (BAND) {
                    const int kp0 = kc * 64 + sub * 32;
                    if (qp0 - (kp0 + 31) >= 128) { const float bfar = bt[256];
#pragma unroll
                        for (int qb = 0; qb < QB; ++qb)
#pragma unroll
                            for (int u = 0; u < 2; ++u) s[u][qb] += bfar;
                    } else {
#pragma unroll
                        for (int qb = 0; qb < QB; ++qb)
#pragma unroll
                            for (int u = 0; u < 2; ++u)
#pragma unroll
                                for (int i = 0; i < 4; ++i) { int rel = (qp0 + 16 * qb + fr) - (kp0 + 16 * u + 4 * fq + i); rel = rel < -128 ? -128 : (rel > 128 ? 128 : rel); s[u][qb][i] += bt[rel + 128]; }
                    }
                }
                softmax_step<HD, QB>(s, vall, m, l, o, pf);
                pv_tile<HD, QB, BPITCH>(o, pf, lds + (2 + buf) * BK_BYTES + sub * 32 * BPITCH, lane);
            }
        }
        if (kc + 1 < kc_hi) SB_WRITE(buf ^ 1);
        __syncthreads();
    }
#undef SB_ISSUE
#undef SB_WRITE
    float inv[QB];
#pragma unroll
    for (int qb = 0; qb < QB; ++qb) { float t = l[qb]; t += __shfl_xor(t, 16); t += __shfl_xor(t, 32); inv[qb] = 1.0f / t; }
    store_o<HD, QB>(o, inv, ao + (size_t)(32 * wave) * AOW, 32, fr, fq);
}

template <bool SEG1>
__device__ __forceinline__ void stick_item(const bf16* q, int q0, bf16* ao,
                                           const char* k1, const char* v1, size_t pitch1, int n1,
                                           const char* k2, const char* v2, size_t pitch2, int n2,
                                           LAS char* vt, int lane) {
    constexpr int HD = 256;
    const int fr = lane & 15, fq = lane >> 4;
    bf16x8 qf[1][HD / 32]; load_q<HD, 1>(qf, q, fr, fq);
    f32x4 o[HD / 16][1];
#pragma unroll
    for (int c = 0; c < HD / 16; ++c) o[c][0] = (f32x4){0.f, 0.f, 0.f, 0.f};
    float R = 0.f; f32x4 s[2][1]; bf16x8 pf[1]; bool done = false;
    for (int key0 = (q0 >> 5) << 5; key0 >= 0; key0 -= 32) {
        qk_tile<HD, 1, false>(s, qf, k2, pitch2, key0, n2 - 1, fr, fq);
        stage_v<HD, false>(vt, v2, pitch2, key0, n2 - 1, lane);
        unsigned vm = 0u;
#pragma unroll
        for (int u = 0; u < 2; ++u)
#pragma unroll
            for (int i = 0; i < 4; ++i) { const int kk = key0 + 16 * u + 4 * fq + i; if (kk < n2 && kk < q0 + fr) vm |= 1u << (4 * u + i); }
        stick_step(s, vm, R, pf[0], fq);
        pv_tile<HD, 1>(o, pf, vt, lane);
#if SB_EARLY
        if (__all(R > 110.0f)) { done = true; break; }
#endif
    }
    if constexpr (SEG1) {
        if (!done) for (int key0 = n1 - 32; key0 >= 0; key0 -= 32) {
            { GAS const char* a_ = (GAS const char*)k1; GAS const char* b_ = (GAS const char*)v1; asm volatile("" : "+s"(a_), "+s"(b_)); k1 = (const char*)a_; v1 = (const char*)b_; }
            qk_tile<HD, 1, true>(s, qf, k1, pitch1, key0, n1 - 1, fr, fq);
            stage_v<HD, true>(vt, v1, pitch1, key0, n1 - 1, lane);
            stick_step(s, 0xffu, R, pf[0], fq);
            pv_tile<HD, 1>(o, pf, vt, lane);
#if SB_EARLY
            if (__all(R > 110.0f)) break;
#endif
        }
    }
    const float inv[1] = {1.0f};
    store_o<HD, 1>(o, inv, ao, 16, fr, fq);
}

constexpr int SPITCH = 528, SK_BYTES = 32 * SPITCH;
__device__ __forceinline__ void stick_block(const bf16* q  , bf16* ao, const char* kbase, const char* vbase, size_t pitchB, int Q0, LAS char* lds, int tid) {
    constexpr int HD = 256;
    const int lane = tid & 63, wave = __builtin_amdgcn_readfirstlane(tid >> 6), fr = lane & 15, fq = lane >> 4;
    const int srow = tid >> 5, sch = tid & 31;
    bf16x8 pk[2], pw[2];
#define ST_ISSUE(kt) do { _Pragma("unroll") for (int i_ = 0; i_ < 2; ++i_) { const size_t go_ = (size_t)((kt) * 32 + srow + 16 * i_) * pitchB + sch * 16; \
        pk[i_] = *(const bf16x8*)(kbase + go_); pw[i_] = *(const bf16x8*)(vbase + go_); } } while (0)
#define ST_WRITE(buf) do { _Pragma("unroll") for (int i_ = 0; i_ < 2; ++i_) { const int lo_ = (srow + 16 * i_) * SPITCH + sch * 16; \
        *(LAS bf16x8*)(lds + (buf) * SK_BYTES + lo_) = pk[i_]; *(LAS bf16x8*)(lds + (2 + (buf)) * SK_BYTES + lo_) = pw[i_]; } } while (0)
    const int kt_hi = (Q0 >> 5) + 3, q0w = Q0 + 16 * wave, dt = q0w >> 5;
    ST_ISSUE(kt_hi);
    volatile LAS int* fl = (volatile LAS int*)(lds + 4 * SK_BYTES);
    bf16x8 qf[1][HD / 32]; load_q<HD, 1>(qf, q + (size_t)(16 * wave) * QKVW, fr, fq);
    f32x4 o[HD / 16][1];
#pragma unroll
    for (int c = 0; c < HD / 16; ++c) o[c][0] = (f32x4){0.f, 0.f, 0.f, 0.f};
    float R = 0.f; int mydone = 0;
    ST_WRITE(0);
    __syncthreads();
    for (int kt = kt_hi; kt >= 0; --kt) {
        const int buf = (kt_hi - kt) & 1;
        if (kt > 0) ST_ISSUE(kt - 1);
        if (!mydone && kt <= dt) {
            f32x4 s[2][1]; bf16x8 pf[1];
            qk_tile_lds<1, HD, SPITCH>(s, qf, lds + buf * SK_BYTES, fr, fq);
            unsigned vm = 0xffu;
            if (kt == dt) { vm = 0u;
#pragma unroll
                for (int u = 0; u < 2; ++u)
#pragma unroll
                    for (int i = 0; i < 4; ++i) if (kt * 32 + 16 * u + 4 * fq + i < q0w + fr) vm |= 1u << (4 * u + i); }
            stick_step(s, vm, R, pf[0], fq);
            pv_tile<HD, 1, SPITCH>(o, pf, lds + (2 + buf) * SK_BYTES, lane);
#if SB_EARLY
            if (__all(R > 110.0f)) mydone = 1;
#endif
        }
        if (kt > 0) ST_WRITE(buf ^ 1);
        if (lane == 0) fl[buf * 8 + wave] = mydone;
        __syncthreads();
        int alld = 1;
#pragma unroll
        for (int w = 0; w < 8; ++w) alld &= fl[buf * 8 + w];
        if (alld) break;
    }
#undef ST_ISSUE
#undef ST_WRITE
    const float inv[1] = {1.0f};
    store_o<HD, 1>(o, inv, ao + (size_t)(16 * wave) * AOW, 16, fr, fq);
    __syncthreads();
}

__device__ __forceinline__ void stick_sample_split(const bf16* q, bf16* ao, const char* k1, const char* v1, size_t pitch1, int n1,
                                                   const char* k2, const char* v2, size_t pitch2, int n2, LAS char* lds0, int wave, int lane) {
    constexpr int HD = 256;
    const int fr = lane & 15, fq = lane >> 4;
    LAS char* vt = lds0 + wave * VT_STRIDE;
    LAS float* tw = (LAS float*)(lds0 + 139264);
    {
        bf16x8 qf[1][HD / 32]; load_q<HD, 1>(qf, q, fr, fq);
        f32x4 o[HD / 16][1];
#pragma unroll
        for (int c = 0; c < HD / 16; ++c) o[c][0] = (f32x4){0.f, 0.f, 0.f, 0.f};
        float R = 0.f; f32x4 s[2][1]; bf16x8 pf[1]; unsigned vm = 0xffu;
        if (wave == 0) {
            qk_tile<HD, 1, false>(s, qf, k2, pitch2, 0, n2 - 1, fr, fq);
            stage_v<HD, false>(vt, v2, pitch2, 0, n2 - 1, lane);
            vm = 0u;
#pragma unroll
            for (int u = 0; u < 2; ++u)
#pragma unroll
                for (int i = 0; i < 4; ++i) { const int kk = 16 * u + 4 * fq + i; if (kk < n2 && kk < fr) vm |= 1u << (4 * u + i); }
        } else {
            const int key0 = n1 - 32 * wave;
            qk_tile<HD, 1, true>(s, qf, k1, pitch1, key0, n1 - 1, fr, fq);
            stage_v<HD, true>(vt, v1, pitch1, key0, n1 - 1, lane);
        }
        stick_step(s, vm, R, pf[0], fq);
        pv_tile<HD, 1>(o, pf, vt, lane);
        LDS_WAIT();
        LAS f32x4* po = (LAS f32x4*)vt;
#pragma unroll
        for (int c = 0; c < HD / 16; ++c) po[c * 64 + lane] = o[c][0];
        tw[wave * 64 + lane] = R;
    }
    __syncthreads();
    float Rl[8], Rtot = 0.f;
#pragma unroll
    for (int w = 0; w < 8; ++w) { Rl[w] = fexp(-Rtot); Rtot += tw[w * 64 + lane]; }
    const bool fast = __all(Rtot > 110.0f);
    if (fast) {
        int fr2 = fr, fq2 = fq; asm volatile("" : "+v"(fr2), "+v"(fq2));
#pragma unroll
        for (int cc = 0; cc < 2; ++cc) { const int c = 2 * wave + cc; f32x4 a = {0.f, 0.f, 0.f, 0.f};
#pragma unroll
            for (int w = 0; w < 8; ++w) a += ((const LAS f32x4*)(lds0 + w * VT_STRIDE))[c * 64 + lane] * Rl[w];
            u32x2 wv; wv.x = pkbf(a.x, a.y); wv.y = pkbf(a.z, a.w);
            *(u32x2*)(ao + (size_t)fr2 * AOW + 16 * c + 4 * fq2) = wv; }
    }
    __syncthreads();
    if (!fast && wave == 0) stick_item<true>(q, 0, ao, k1, v1, pitch1, n1, k2, v2, pitch2, n2, vt, lane);
    __syncthreads();
}
}

struct P0Item { const float* W; bf16* WT; const float* gain; float scale; int K, N, ffn_up, item; };
__device__ __forceinline__ void p0_load(const P0Item& d, f32x4 (&v)[8], int lane) {
    const int nblk = d.N / 32, kb = d.item / nblk, nb = d.item % nblk, k0 = 64 * kb, n0 = 32 * nb;
    const float* p = d.W + (size_t)(k0 + (lane >> 3)) * d.N + n0 + 4 * (lane & 7);
#pragma unroll
    for (int i = 0; i < 8; ++i) v[i] = *(const f32x4*)(p + (size_t)(8 * i) * d.N);
}
__device__ __forceinline__ void p0_store(const P0Item& d, const f32x4 (&v)[8], LAS float* scr, int lane) {
    const int nblk = d.N / 32, kb = d.item / nblk, nb = d.item % nblk, k0 = 64 * kb, n0 = 32 * nb;
    int r0 = n0;
    if (d.ffn_up) { const int j0 = n0 < DFF ? n0 : n0 - DFF; r0 = 256 * (j0 >> 7) + (n0 < DFF ? 0 : 128) + (j0 & 127); }
#pragma unroll
    for (int i = 0; i < 8; ++i) { const int kk = 8 * i + (lane >> 3); const float g = d.gain ? d.gain[k0 + kk] * d.scale : d.scale;
        *(LAS f32x4*)(scr + kk * 36 + 4 * (lane & 7)) = v[i] * g; }
    LDS_WAIT(); asm volatile("" ::: "memory");
    const int c = lane & 7;
#pragma unroll
    for (int j = 0; j < 4; ++j) { const int n = (lane >> 3) + 8 * j; const LAS float* s = scr + (8 * c) * 36 + n;
        u32x4 o; o.x = pkbf(s[0 * 36], s[1 * 36]); o.y = pkbf(s[2 * 36], s[3 * 36]); o.z = pkbf(s[4 * 36], s[5 * 36]); o.w = pkbf(s[6 * 36], s[7 * 36]);
        *(u32x4*)(d.WT + (size_t)(r0 + n) * d.K + k0 + 8 * c) = o; }
    LDS_WAIT(); asm volatile("" ::: "memory");
}
__device__ __forceinline__ float wave_sum(float v) {
#pragma unroll
    for (int o = 1; o < 64; o <<= 1) v += __shfl_xor(v, o);
    return v;
}
__device__ __forceinline__ void p0_row(const float* xrow, bf16* orow, float* ssq_row, int norm, int lane) {
    const f32x4* xr = (const f32x4*)xrow + lane;
    f32x4 v[8]; float s = 0.f;
#pragma unroll
    for (int j = 0; j < 8; ++j) { v[j] = xr[64 * j]; s += dot4(v[j]); }
    s = wave_sum(s);
    const float sc = norm ? __builtin_amdgcn_rsqf(s * (1.0f / DM) + EPS) : 1.0f;
    u32x2* o8 = (u32x2*)orow + lane;
#pragma unroll
    for (int j = 0; j < 8; ++j) { u32x2 w; w.x = pkbf(v[j].x * sc, v[j].y * sc); w.y = pkbf(v[j].z * sc, v[j].w * sc); o8[64 * j] = w; }
    if (ssq_row && lane < 8) ssq_row[lane] = lane == 0 ? s : 0.f;
}

template <class Sched> __device__ __forceinline__ void run_up(LAS unsigned char* lds, const bf16* A, const bf16* Bt, const Sched& S, bf16* HB, const float* ssq, int& tidv) {
    pg8::Gemm g{A, Bt, MR, 2 * DFF, DM}; EpiSwiGLU E{HB, ssq, (LAS float*)(lds + TAB2_OFF)}; pg8::gemm_phase<EpiSwiGLU, Sched, true, true>(lds, g, S, E, tidv); }
template <bool APAIR, class Sched> __device__ __forceinline__ void run_resid(LAS unsigned char* lds, const bf16* A, const bf16* Bt, int K, const Sched& S, bf16* XB, float* outf, float* ssq_out, LAS float* tab, int& tidv) {
    pg8::Gemm g{A, Bt, MR, DM, K}; EpiResid E{XB, outf, ssq_out, tab}; pg8::gemm_phase<EpiResid, Sched, true, true, APAIR>(lds, g, S, E, tidv); }
template <class Sched> __device__ __forceinline__ void run_qkv(LAS unsigned char* lds, const bf16* A, const bf16* Bt, const Sched& S, const EpiQKV& E, int& tidv) {
    pg8::Gemm g{A, Bt, MRX, INW, DM}; pg8::gemm_phase<EpiQKV, Sched, true, true>(lds, g, S, E, tidv); }
struct Params { const float* in[25]; float* out; unsigned char* ws; int ph_lo, ph_hi, bar_idx, pad; };
__global__ void __launch_bounds__(512, 2) fwd(Params P) {
    extern __shared__ __attribute__((aligned(16))) unsigned char lds_raw[];
    LAS unsigned char* lds = (LAS unsigned char*)lds_raw;
    int tidv = threadIdx.x;
    const int tid = tidv, lane = tid & 63, wave = __builtin_amdgcn_readfirstlane(tid >> 6);
    const int G = gridDim.x, gw = blockIdx.x * 8 + wave, NGW = G * 8;
    unsigned char* ws = P.ws; float* out = P.out;
    volatile LAS unsigned* MISC = (volatile LAS unsigned*)(lds + MISC_OFF);
    if (tid < 32) MISC[tid] = 0u;
    __syncthreads();
    unsigned* ctl = (unsigned*)(ws + WS_CTL);
    XcdBarrier bar; bar.bar = ctl + 4096; bar.x = 0; bar.st = nullptr;
    if (!MK_MULTI) bar = xcd_barrier_post(ctl + 4096, MISC + 8);
    const int lo = P.ph_lo, hi = P.ph_hi;
#define IN(k) (lo <= (k) && (k) < hi)
#define SEAM(k) do { if (IN(k) && IN((k) + 1)) { XcdBarrier b_ = bar; { GAS unsigned* t_ = (GAS unsigned*)bar.bar; asm volatile("" : "+s"(t_), "+s"(b_.x)); b_.bar = (unsigned*)t_; } xcd_barrier(b_); } } while (0)
#define STAGGER() do { if (STAGGER_US > 0) { const unsigned long long t0_ = __builtin_amdgcn_s_memrealtime(), d_ = (unsigned long long)(blockIdx.x % 256u) * (unsigned)(STAGGER_US * 100) / 256u; \
        while (__builtin_amdgcn_s_memrealtime() - t0_ < d_) __builtin_amdgcn_s_sleep(4); } } while (0)
    bf16* XB = (bf16*)(ws + WS_XB); bf16* HB = (bf16*)(ws + WS_H); bf16* QKV = (bf16*)(ws + WS_QKV); bf16* AO = (bf16*)(ws + WS_AO); bf16* MKV = (bf16*)(ws + WS_MKV);
    float* SSQ = (float*)(ws + WS_SSQ);
    LAS float* TAB1 = (LAS float*)(lds + TAB1_OFF); LAS float* TAB2 = (LAS float*)(lds + TAB2_OFF);

    for (int rep = 0; rep < 1 + DUP_P0; ++rep) if (IN(0)) {
        LAS float* scr = (LAS float*)(lds + wave * 16384);
        constexpr int I_U = (DM / 64) * (2 * DFF / 32), I_D = (DFF / 64) * (DM / 32), I_IN = (DM / 64) * (QKVW / 32), I_MK = (DM / 64) * (1024 / 32), I_O = (AOW / 64) * (DM / 32);
        constexpr int I_LAYER = 2 * I_U + 2 * I_D + I_IN + I_MK + I_O, I_W = NLAYER * I_LAYER, I_ALL = I_W + MRX;
        auto decode = [&](int it) {
            P0Item d; const int l = it / I_LAYER; int r = it % I_LAYER;
            char* LW = (char*)(ws + WS_W + (size_t)l * LW_SIZE);
            d.gain = nullptr; d.scale = 1.0f; d.ffn_up = 0;
            if (r < I_U) { d.W = P.in[10] + (size_t)l * DM * 2 * DFF; d.K = DM; d.N = 2 * DFF; d.WT = (bf16*)(LW + LW_1U); d.gain = P.in[9] + l * DM; d.ffn_up = 1; d.item = r; return d; } r -= I_U;
            if (r < I_D) { d.W = P.in[11] + (size_t)l * DFF * DM; d.K = DFF; d.N = DM; d.WT = (bf16*)(LW + LW_1D); d.scale = 0.5f; d.item = r; return d; } r -= I_D;
            if (r < I_IN) { d.W = P.in[13] + (size_t)l * DM * QKVW; d.K = DM; d.N = QKVW; d.WT = (bf16*)(LW + LW_IN); d.gain = P.in[12] + l * DM; d.item = r; return d; } r -= I_IN;
            if (r < I_MK) { d.W = P.in[19] + (size_t)l * DM * 1024; d.K = DM; d.N = 1024; d.WT = (bf16*)(LW + LW_IN) + (size_t)QKVW * DM; d.gain = P.in[18] + l * DM; d.item = r; return d; } r -= I_MK;
            if (r < I_O) { d.W = P.in[14] + (size_t)l * AOW * DM; d.K = AOW; d.N = DM; d.WT = (bf16*)(LW + LW_O); d.item = r; return d; } r -= I_O;
            if (r < I_U) { d.W = P.in[23] + (size_t)l * DM * 2 * DFF; d.K = DM; d.N = 2 * DFF; d.WT = (bf16*)(LW + LW_2U); d.gain = P.in[22] + l * DM; d.ffn_up = 1; d.item = r; return d; } r -= I_U;
            d.W = P.in[24] + (size_t)l * DFF * DM; d.K = DFF; d.N = DM; d.WT = (bf16*)(LW + LW_2D); d.scale = 0.5f; d.item = r; return d;
        };
        {
            int it = gw; f32x4 va[8], vb[8]; P0Item da, db;
            if (it < I_W) { da = decode(it); p0_load(da, va, lane); }
            while (it < I_W) {
                const int itn = it + NGW;
                if (itn < I_W) { db = decode(itn); p0_load(db, vb, lane); }
                p0_store(da, va, scr, lane);
                it = itn;
                if (it >= I_W) break;
                const int itn2 = it + NGW;
                if (itn2 < I_W) { da = decode(itn2); p0_load(da, va, lane); }
                p0_store(db, vb, scr, lane);
                it = itn2;
            }
        }
        for (int m = gw; m < MRX; m += NGW) {
            const float* src = m < NP ? P.in[0] + (size_t)m * DM : m < MR ? P.in[1] + (size_t)(m - NP) * DM : P.in[2] + (size_t)(m - MR) * DM;
            p0_row(src, XB + (size_t)m * DM, m < MR ? SSQ + (size_t)m * 8 : nullptr, m >= MR, lane);
        }
    }
    if (IN(0) && blockIdx.x == 0) {
        float* gd = (float*)(ws + WS_DBG);
        for (int i = tid; i < NLAYER * 512; i += 512) { const int l = i >> 9, k = (i >> 7) & 3, d = i & 127;
            gd[i] = k == 0 ? P.in[15][(l >> 1) * 128 + d] : k == 1 ? P.in[16][(l >> 1) * 128 + d] : k == 2 ? P.in[20][l * 128 + d] : P.in[21][l * 128 + d]; }
    }
    SEAM(0);

    int dbase = 0;
    for (int l = 0; l < NLAYER; ++l) {
        const int pb = 1 + 7 * l, e = l & 1, j = l >> 1;
        if (hi <= pb || lo >= pb + 7) continue;
        GAS unsigned char* wsg_ = (GAS unsigned char*)P.ws; GAS float* outg_ = (GAS float*)P.out; asm volatile("" : "+s"(wsg_), "+s"(outg_));
        unsigned char* ws = (unsigned char*)wsg_; float* out = (float*)outg_;
        bf16* XB = (bf16*)(ws + WS_XB); bf16* HB = (bf16*)(ws + WS_H); bf16* QKV = (bf16*)(ws + WS_QKV); bf16* AO = (bf16*)(ws + WS_AO); bf16* MKV = (bf16*)(ws + WS_MKV);
        float* SSQ = (float*)(ws + WS_SSQ); unsigned* ctl = (unsigned*)(ws + WS_CTL);
        const char* LW = (const char*)(ws + WS_W + (size_t)l * LW_SIZE);
        float* ssqA = SSQ + (size_t)e * SSQ_BUF; float* ssqB = SSQ + (size_t)(1 - e) * SSQ_BUF;
#define PCW(s_) (ctl + PC_WORD0 + (size_t)((l * 5 + (s_)) * 132) * PC_STRIDE)
#define TMOW (ctl + 4096 + XB_TMO)
#define W0 (__builtin_amdgcn_readfirstlane(tidv >> 6) == 0)
        if (IN(pb + 0)) {
            int bx = blockIdx.x; asm volatile("" : "+s"(bx));
            Gated<XcdDeal> S; S.init(24, 48, bx, dbase); S.rdy = -1; S.g = Gate{l > 0 ? PCW(0) : nullptr, 64u, PCW(1), TMOW, W0};
            run_up(lds, XB, (const bf16*)(LW + LW_1U), S, HB, ssqA, tidv);
        }
        if (IN(pb + 1)) {
            Gated<XcdDeal> S; int bx = blockIdx.x; asm volatile("" : "+s"(bx)); S.init(8, 16, bx, dbase); S.rdy = -1; S.g = Gate{PCW(1), 192u, PCW(2), TMOW, W0};
            run_resid<true>(lds, HB, (const bf16*)(LW + LW_1D), DFF, S, XB, nullptr, ssqB, TAB1, tidv);
        }
        if (IN(pb + 2)) {
            Gated<DynDeal> S; int bx = blockIdx.x; asm volatile("" : "+s"(bx)); S.nN = 14; S.T = 36; S.x = bx & 7; S.w0 = W0; S.ctr = ctl + DC_WORD0 + (l * 2 + 0) * 128; S.par = 0; S.rdy = -1; S.g = Gate{PCW(2), 64u, ctl + BC_WORD0 + 64 * l, TMOW, W0, 1};
            EpiQKV E{QKV, MKV + (size_t)l * NMR * 1024, ssqB, (const float*)(ws + WS_DBG) + l * 512, out, l, TAB2, (LAS float*)(lds + TAB3_OFF)};
            run_qkv(lds, XB, (const bf16*)(LW + LW_IN), S, E, tidv);
        }
        if (IN(pb + 3)) {
            asm volatile("" : "+v"(tidv)); __builtin_assume(tidv >= 0 && tidv < 512); const int tid_ = tidv;
            const int tid = tid_, lane = tid_ & 63;
            unsigned* qctr = ctl + 65536 + 64 * 4 * l;
            volatile LAS int* dq = (volatile LAS int*)(lds + MISC_OFF + 64);
            unsigned* bcw = ctl + BC_WORD0 + 64 * l; int rdymask = 0;
#define WAIT_CTR(idx_) do { if (!((rdymask >> (idx_)) & 1)) { if (tid == 0) { const unsigned nd_ = (idx_) < 2 ? 64u * 14u * 8u : (idx_) == 2 ? 2u * 14u * 8u : 64u; const unsigned* p_ = bcw + 16 * (idx_); unsigned sp_ = 0; \
                while (__hip_atomic_load(p_, RLX_AGENT) < nd_) { if ((++sp_ & 255u) == 0u) { if (__hip_atomic_load(TMOW, RLX_AGENT) != 0u) break; if (sp_ > (1u << 18)) { __hip_atomic_store(TMOW, 1u, RLX_AGENT); break; } } __builtin_amdgcn_s_sleep(2); } \
                __builtin_amdgcn_fence(__ATOMIC_ACQUIRE, "agent"); asm volatile("s_waitcnt vmcnt(0)" ::: "memory"); } \
            __syncthreads(); rdymask |= 1 << (idx_); } } while (0)
#define DYN_ITEMS(ctr, N, ...) do { int cur_; if (tid == 0) dq[0] = (int)__hip_atomic_fetch_add((ctr), 1u, __ATOMIC_RELAXED, __HIP_MEMORY_SCOPE_AGENT); \
                __syncthreads(); cur_ = __builtin_amdgcn_readfirstlane(dq[0]); __syncthreads(); \
                while (cur_ < (N)) { int nx_ = 0; if (tid == 0) nx_ = (int)__hip_atomic_fetch_add((ctr), 1u, __ATOMIC_RELAXED, __HIP_MEMORY_SCOPE_AGENT); \
                    const int it = cur_; __VA_ARGS__; \
                    if (tid == 0) dq[0] = nx_; __syncthreads(); cur_ = __builtin_amdgcn_readfirstlane(dq[0]); __syncthreads(); } } while (0)
            if (!e) {
                const float* relb = P.in[17] + (size_t)j * 8 * 257;
                DYN_ITEMS(qctr + 64, NB * 8 * (SEQ / 256), {
                    const int qb = it % (SEQ / 256), h = (it / (SEQ / 256)) % 8, b = it / (8 * (SEQ / 256)), c0 = qb * 4;
                    WAIT_CTR(b);
                    const bf16* rowb = QKV + (size_t)b * SEQ * QKVW;
                    att::softmax_block<true>(rowb + (size_t)(qb * 256) * QKVW + h * 128, AO + (size_t)(b * SEQ + qb * 256) * AOW + h * 128,
                                             (const char*)(rowb + TOKW + h * 128), (const char*)(rowb + 2 * TOKW + h * 128), (size_t)QKVW * 2,
                                             c0 >= 8 ? c0 - 8 : 0, c0 + 4, c0, relb + h * 257, (LAS char*)lds, tid);
                });
                DYN_ITEMS(qctr, DBAT * 4, {
                    WAIT_CTR(2);
                    const int it2 = it * 2 + (wave >> 2), sp = wave & 3, h = it2 % 8, sb = it2 / 8;
                    const bf16* rowb = QKV + (size_t)(NP + sb * DSEQ) * QKVW;
                    const float* ck = P.in[3] + ((size_t)(j * DBAT + sb) * ACACHE) * TOKW + h * 128; const float* cv = P.in[4] + ((size_t)(j * DBAT + sb) * ACACHE) * TOKW + h * 128;
                    att::softmax_item<1, true, 4>(rowb + h * 128, PAST, AO + (size_t)(NP + sb * DSEQ) * AOW + h * 128,
                                                  (const char*)ck, (const char*)cv, (size_t)TOKW * 4, sp * 128, sp * 128 + 128, ACACHE, PAST - ACACHE,
                                                  (const char*)(rowb + TOKW + h * 128), (const char*)(rowb + 2 * TOKW + h * 128), (size_t)QKVW * 2, 0, sp == 3 ? 32 : 0, DSEQ, PAST,
                                                  relb + h * 257, (LAS char*)lds, wave, lane);
                });
            } else {
                DYN_ITEMS(qctr + 64, NB * 4 * (SEQ / 128), {
                    const int b = it / (4 * (SEQ / 128)), r_ = it % (4 * (SEQ / 128)), qb = (SEQ / 128) - 1 - r_ / 4, h = r_ & 3, Q0 = qb * 128;
                    WAIT_CTR(b);
                    const bf16* rowb = QKV + (size_t)b * SEQ * QKVW;
                    att::stick_block(rowb + (size_t)Q0 * QKVW + h * 256, AO + (size_t)(b * SEQ + Q0) * AOW + h * 256,
                                     (const char*)(rowb + TOKW + h * 256), (const char*)(rowb + 2 * TOKW + h * 256), (size_t)QKVW * 2, Q0, (LAS char*)lds, tid);
                });
#if SB_EARLY
                DYN_ITEMS(qctr, DBAT * 4, {
                    WAIT_CTR(2);
                    const int h = it % 4, sb = it / 4;
                    const bf16* rowb = QKV + (size_t)(NP + sb * DSEQ) * QKVW;
                    const float* ck = P.in[5] + ((size_t)(j * DBAT + sb) * PAST) * TOKW + h * 256; const float* cv = P.in[6] + ((size_t)(j * DBAT + sb) * PAST) * TOKW + h * 256;
                    att::stick_sample_split(rowb + h * 256, AO + (size_t)(NP + sb * DSEQ) * AOW + h * 256, (const char*)ck, (const char*)cv, (size_t)TOKW * 4, PAST,
                                            (const char*)(rowb + TOKW + h * 256), (const char*)(rowb + 2 * TOKW + h * 256), (size_t)QKVW * 2, DSEQ, (LAS char*)lds, wave, lane);
                });
#else
                WAIT_CTR(0); WAIT_CTR(1); WAIT_CTR(2);
                { LAS char* vt = (LAS char*)lds + wave * VT_STRIDE;
                for (int it = gw; it < DBAT * 4; it += NGW) {
                    const int h = it % 4, sb = it / 4;
                    const bf16* rowb = QKV + (size_t)(NP + sb * DSEQ) * QKVW;
                    const float* ck = P.in[5] + ((size_t)(j * DBAT + sb) * PAST) * TOKW + h * 256; const float* cv = P.in[6] + ((size_t)(j * DBAT + sb) * PAST) * TOKW + h * 256;
                    att::stick_item<true>(rowb + h * 256, 0, AO + (size_t)(NP + sb * DSEQ) * AOW + h * 256,
                                          (const char*)ck, (const char*)cv, (size_t)TOKW * 4, PAST,
                                          (const char*)(rowb + TOKW + h * 256), (const char*)(rowb + 2 * TOKW + h * 256), (size_t)QKVW * 2, DSEQ, vt, lane);
                }
                __syncthreads(); }
#endif
            }
            DYN_ITEMS(qctr + 192, NB * 4 * (SEQ / 256), {
                const int qb = it % (SEQ / 256), h = (it / (SEQ / 256)) % 4, b = it / (4 * (SEQ / 256));
                WAIT_CTR(b); WAIT_CTR(3);
                const bf16* kb = MKV + (size_t)l * NMR * 1024 + (size_t)b * NMEM * 1024 + h * 128;
                att::softmax_block<false>(QKV + (size_t)(b * SEQ + qb * 256) * QKVW + 3 * TOKW + h * 128, AO + (size_t)(b * SEQ + qb * 256) * AOW + TOKW + h * 128,
                                          (const char*)kb, (const char*)(kb + MEMW), (size_t)1024 * 2, 0, NMEM / 64, 0, nullptr, (LAS char*)lds, tid);
            });
            DYN_ITEMS(qctr + 128, DBAT * 2, {
                WAIT_CTR(2); WAIT_CTR(3);
                const int it2 = it * 2 + (wave >> 2), sp = wave & 3, h = it2 % 4, sb = it2 / 4;
                const float* ck = P.in[7] + ((size_t)(l * DBAT + sb) * NMEM) * MEMW + h * 128; const float* cv = P.in[8] + ((size_t)(l * DBAT + sb) * NMEM) * MEMW + h * 128;
                att::softmax_item<1, true, 4>(QKV + (size_t)(NP + sb * DSEQ) * QKVW + 3 * TOKW + h * 128, 0, AO + (size_t)(NP + sb * DSEQ) * AOW + TOKW + h * 128,
                                              (const char*)ck, (const char*)cv, (size_t)MEMW * 4, sp * 64, sp * 64 + 64, NMEM, 0,
                                              nullptr, nullptr, 0, 0, 0, 1, 0, nullptr, (LAS char*)lds, wave, lane);
            });
#undef DYN_ITEMS
#undef WAIT_CTR
        }
        SEAM(pb + 3);
        if (IN(pb + 4)) {
            dbase = 0; Gated<XcdDeal> S; int bx = blockIdx.x; asm volatile("" : "+s"(bx)); S.init(8, 16, bx, dbase); S.rdy = -1; S.g = Gate{nullptr, 0u, PCW(3), TMOW, W0};
            run_resid<false>(lds, AO, (const bf16*)(LW + LW_O), AOW, S, XB, nullptr, ssqA, TAB1, tidv);
        }
        if (IN(pb + 5)) {
            int bx = blockIdx.x; asm volatile("" : "+s"(bx));
            Gated<XcdDeal> S; S.init(24, 48, bx, dbase); S.rdy = -1; S.g = Gate{PCW(3), 64u, PCW(4), TMOW, W0};
            run_up(lds, XB, (const bf16*)(LW + LW_2U), S, HB, ssqA, tidv);
        }
        if (IN(pb + 6)) {
            Gated<DynDeal> S; int bx = blockIdx.x; asm volatile("" : "+s"(bx)); S.nN = 8; S.T = 16; S.x = bx & 7; S.w0 = W0; S.ctr = ctl + DC_WORD0 + (l * 2 + 1) * 128; S.par = 0; dbase += 130; S.rdy = -1; S.g = Gate{PCW(4), 192u, l + 1 < NLAYER ? PCW(5) : nullptr, TMOW, W0};
            run_resid<true>(lds, HB, (const bf16*)(LW + LW_2D), DFF, S, XB, l == NLAYER - 1 ? out : nullptr, ssqB, TAB1, tidv);
        }
    }
#undef IN
#undef SEAM
#undef PCW
#undef TMOW
#undef W0
}

extern "C" void kernel_launch(void* const* d_in, const int* in_sizes, int n_in, void* d_out, int out_size, void* d_ws, size_t ws_size, hipStream_t stream) {
    static int grid = 0;
    if (grid == 0) {
        if (n_in != 25 || (size_t)out_size != O_END || ws_size < WS_END) { fprintf(stderr, "kernel_launch: unexpected shapes (n_in %d out %d ws %zu)\n", n_in, out_size, ws_size); grid = -1; return; }
        int dev = 0, cus = 0, per_cu = 0;
        if (hipGetDevice(&dev) != hipSuccess || hipDeviceGetAttribute(&cus, hipDeviceAttributeMultiprocessorCount, dev) != hipSuccess) { grid = -1; return; }
        if (hipFuncSetAttribute((const void*)fwd, hipFuncAttributeMaxDynamicSharedMemorySize, LDS_BYTES) != hipSuccess) { fprintf(stderr, "kernel_launch: hipFuncSetAttribute failed\n"); grid = -1; return; }
        if (hipOccupancyMaxActiveBlocksPerMultiprocessor(&per_cu, (const void*)fwd, 512, LDS_BYTES) != hipSuccess || per_cu < 1) { fprintf(stderr, "kernel_launch: occupancy query says %d\n", per_cu); (void)hipGetLastError(); grid = -1; return; }
        if (cus < 256) { fprintf(stderr, "kernel_launch: %d CUs; this kernel's unit orders are built for 256 resident workgroups\n", cus); grid = -1; return; }
        grid = 256;
    }
    if (grid < 0) return;
    (void)hipMemsetAsync((char*)d_ws + WS_CTL, 0, CTL_ZERO_BYTES, stream);
    Params p; memset(&p, 0, sizeof(p));
    for (int i = 0; i < 25; ++i) p.in[i] = (const float*)d_in[i];
    p.out = (float*)d_out; p.ws = (unsigned char*)d_ws;
#if MK_MULTI
    for (int k = 0; k < NPH; ++k) { p.ph_lo = k; p.ph_hi = k + 1; hipLaunchKernelGGL(fwd, dim3(grid), dim3(512), LDS_BYTES, stream, p); }
#else
    p.ph_lo = 0; p.ph_hi = NPH; hipLaunchKernelGGL(fwd, dim3(grid), dim3(512), LDS_BYTES, stream, p);
#endif
}
```

```cpp
#include <hip/hip_runtime.h>
#include <cstdio>
#include <cstdint>
#include <cstring>
#ifndef MK_MULTI
#define MK_MULTI 0
#endif
#ifndef SB_EARLY
#define SB_EARLY 1
#endif
#ifndef DUP_P0
#define DUP_P0 0
#endif
#ifndef DUP_G1
#define DUP_G1 0
#endif
#ifndef DUP_G3
#define DUP_G3 0
#endif
#ifndef DUP_ATTA
#define DUP_ATTA 0
#endif
#ifndef DUP_ATTB
#define DUP_ATTB 0
#endif
#ifndef STAGGER_US
#define STAGGER_US 0
#endif
namespace pg8 {
#define PG8_LAS __attribute__((address_space(3)))
typedef unsigned short bf16_t;
typedef short bf16x8 __attribute__((ext_vector_type(8)));
typedef float f32x4 __attribute__((ext_vector_type(4)));
typedef unsigned u32x4 __attribute__((ext_vector_type(4)));
constexpr int BM = 256, BK = 64, HALF = 128, HTB = HALF * BK * 2  , STAGE_BYTES = 8 * HTB, NXCD = 8, WGM = 8;

__host__ __device__ __forceinline__ int lds_byte(int r, int c) { const int st = (r >> 4) * 2 + (c >> 5), rr = r & 15, cc = c & 31, ob = rr * 64 + cc * 2; return st * 1024 + (ob ^ (((ob >> 9) & 1) << 5)); }
__host__ __device__ __forceinline__ void stage_rc(int b, int& R, int& C) { const int st = b / 1024, sb = b % 1024, swz = sb ^ (((sb >> 9) & 1) << 5); R = (st >> 1) * 16 + swz / 64; C = (st & 1) * 32 + (swz % 64) / 2; }
__host__ __device__ __forceinline__ int perm32(int rho) { const int n = rho >> 4, i = rho & 15; return 8 * (i >> 2) + 4 * n + (i & 3); }

struct Unit { int pm, pn; };
struct Gemm { const bf16_t* A; const bf16_t* Bt; int M, N, K; };

struct StaticOrder {
    int nM, nN, nwg, G, c;
    __host__ __device__ void init(int M, int N, int G_, int c_) { nM = M / BM; nN = N / BM; nwg = nM * nN; G = G_; c = c_; }
    __host__ __device__ bool next(int i, Unit& u) const {
        const long L = (long)i * G + c; if (L >= nwg) return false;
        int wgid = (int)L; { const int q = nwg / NXCD, r = nwg % NXCD, xcd = wgid % NXCD, off = wgid / NXCD; wgid = (xcd < r ? xcd * (q + 1) : r * (q + 1) + (xcd - r) * q) + off; }
        const int nig = WGM * nN, gid = wgid / nig, fm = gid * WGM, gsz = (nM - fm) < WGM ? (nM - fm) : WGM;
        u.pm = fm + ((wgid % nig) % gsz); u.pn = (wgid % nig) / gsz; return true;
    }
    __device__ __forceinline__ void a_ready(const Unit&) const {}
    __device__ __forceinline__ void done(const Unit&) const {}
};

__device__ __forceinline__ unsigned cvt_pk_bf16(float lo, float hi) { unsigned r; asm volatile("v_cvt_pk_bf16_f32 %0, %1, %2" : "=v"(r) : "v"(lo), "v"(hi)); return r; }
typedef float f32x2 __attribute__((ext_vector_type(2)));
template <class Epi, class Sched, bool ALIGN_EPI = false, bool SP2 = false, bool APAIR = false>
__device__ __forceinline__ void gemm_phase(PG8_LAS unsigned char* lds, const Gemm g, const Sched& S, const Epi& E, int& tid_) {
    asm volatile("" : "+v"(tid_));
    const int tid = tid_, wid = __builtin_amdgcn_readfirstlane(tid >> 6), lane = tid & 63, wr = wid >> 2, wc = wid & 3, fr = lane & 15, fq = lane >> 4;
    const int K = g.K, nt = K / BK;
    unsigned voffA[2], voffB[2];
#pragma unroll
    for (int i = 0; i < 2; ++i) { int R, C; stage_rc(tid * 16 + i * 8192, R, C); const int Rb = Epi::ADJ ? (64 * (R >> 5) + perm32(R & 31)) : Epi::PERM ? ((R & ~31) + perm32(R & 31)) : R;
        voffA[i] = APAIR ? (unsigned)((R >> 4) * (16 * K * 2) + (R & 7) * (2 * K * 2) + ((C * 2) >> 6) * 128 + ((R >> 3) & 1) * 64 + ((C * 2) & 63)) : (unsigned)(R * K + C) * 2u;
        voffB[i] = (unsigned)(Rb * K + C) * 2u; }
    const size_t kstep = (size_t)(BK * 2);
    const size_t kstepA = APAIR ? 2 * kstep : kstep;
    const size_t hstep = (size_t)HALF * K * 2;
    const size_t tstep = 2 * hstep;
    const size_t hstepB = Epi::ADJ ? (size_t)32 * K * 2 : hstep;
    const unsigned ldsw = (unsigned)wid * 1024u;
    const int aoff = lds_byte(wr * 64 + fr, fq * 8), boff = lds_byte(wc * 32 + fr, fq * 8);
#define PG8_SA(b, h) (((b) * 2 + (h)) * HTB)
#define PG8_SB(b, h) ((4 + (b) * 2 + (h)) * HTB)
#define PG8_STAGE(bufoff, gbase, voff) do { _Pragma("unroll") for (int _i = 0; _i < 2; ++_i) \
        __builtin_amdgcn_global_load_lds((const unsigned*)((const char*)(gbase) + (voff)[_i]), (PG8_LAS unsigned*)(lds + (bufoff) + ldsw + _i * 8192), 16, 0, 0); } while (0)
#define PG8_LDA(dst, b, h) do { _Pragma("unroll") for (int m = 0; m < 4; ++m) _Pragma("unroll") for (int k = 0; k < 2; ++k) dst[m][k] = *(const PG8_LAS bf16x8*)(lds + PG8_SA(b, h) + aoff + m * 2048 + k * 1024); } while (0)
#define PG8_LDB(dst, b, h) do { _Pragma("unroll") for (int n = 0; n < 2; ++n) _Pragma("unroll") for (int k = 0; k < 2; ++k) dst[n][k] = *(const PG8_LAS bf16x8*)(lds + PG8_SB(b, h) + boff + n * 2048 + k * 1024); } while (0)
#define PG8_MMA(ai, bj, At, Bt) do { __builtin_amdgcn_s_setprio(1); _Pragma("unroll") for (int m = 0; m < 4; ++m) _Pragma("unroll") for (int n = 0; n < 2; ++n) _Pragma("unroll") for (int k = 0; k < 2; ++k) \
        acc[ai][bj][m][n] = __builtin_amdgcn_mfma_f32_16x16x32_bf16(Bt[n][k], At[m][k], acc[ai][bj][m][n], 0, 0, 0); __builtin_amdgcn_s_setprio(0); } while (0)
#define PG8_WAIT_V(n) asm volatile("s_waitcnt vmcnt(" #n ")" ::: "memory")
#define PG8_WAIT_L(n) asm volatile("s_waitcnt lgkmcnt(" #n ")" ::: "memory")
#define PG8_BAR __builtin_amdgcn_s_barrier()
#define PG8_SCHED __builtin_amdgcn_sched_barrier(0)
    Unit cur, nxt; int ui = 0;
    if (!S.next(0, cur)) return;
    f32x4 acc[2][2][4][2];
#pragma unroll
    for (int a = 0; a < 2; ++a)
#pragma unroll
        for (int b = 0; b < 2; ++b)
#pragma unroll
            for (int m = 0; m < 4; ++m)
#pragma unroll
                for (int n = 0; n < 2; ++n) acc[a][b][m][n] = (f32x4){0.f, 0.f, 0.f, 0.f};
    bf16x8 At[4][2], B0[2][2], B1[2][2];
    const char* cA = (const char*)g.A + (size_t)cur.pm * tstep; const char* cB = (const char*)g.Bt + (size_t)cur.pn * tstep;
    S.a_ready(cur);
    if constexpr (SP2) {
        PG8_STAGE(PG8_SB(0, 0), cB, voffB); PG8_STAGE(PG8_SB(0, 1), cB + hstepB, voffB); PG8_STAGE(PG8_SA(0, 0), cA, voffA); PG8_STAGE(PG8_SA(0, 1), cA + hstep, voffA);
        if (wr == 1) PG8_BAR;
        PG8_WAIT_V(2); PG8_BAR;
        PG8_STAGE(PG8_SB(1, 0), cB + kstep, voffB); PG8_STAGE(PG8_SA(1, 0), cA + kstepA, voffA); PG8_STAGE(PG8_SB(1, 1), cB + hstepB + kstep, voffB);
        PG8_WAIT_V(6); PG8_BAR;
    } else {
        PG8_STAGE(PG8_SB(0, 0), cB, voffB); PG8_STAGE(PG8_SA(0, 0), cA, voffA); PG8_STAGE(PG8_SB(0, 1), cB + hstepB, voffB); PG8_STAGE(PG8_SA(0, 1), cA + hstep, voffA);
        if (wr == 1) PG8_BAR;
        PG8_WAIT_V(4); PG8_BAR;
        PG8_STAGE(PG8_SB(1, 0), cB + kstep, voffB); PG8_STAGE(PG8_SA(1, 0), cA + kstepA, voffA); PG8_STAGE(PG8_SB(1, 1), cB + hstepB + kstep, voffB);
        PG8_WAIT_V(6); PG8_BAR;
    }
    for (;;) {
        const bool has_next = S.next(ui + 1, nxt);
        const char* nA = has_next ? (const char*)g.A + (size_t)nxt.pm * tstep : cA; const char* nB = has_next ? (const char*)g.Bt + (size_t)nxt.pn * tstep : cB;
        for (int t = 0; t < nt; t += 2) {
            const bool last = (t == nt - 2);
            const char* a1 = cA + (size_t)(t + 1) * kstepA;
            const char* a2 = last ? nA : cA + (size_t)(t + 2) * kstepA; const char* b2 = last ? nB : cB + (size_t)(t + 2) * kstep;
            const char* a3 = a2 + kstepA; const char* b3 = b2 + kstep;
            if constexpr (Epi::PREFETCH) { if (last) E.prefetch(cur, lds, tid, wid); }
            if (last && has_next) S.a_ready(nxt);
            if constexpr (SP2) {
            PG8_LDB(B0, 0, 0); PG8_LDB(B1, 0, 1); PG8_SCHED; PG8_LDA(At, 0, 0); PG8_STAGE(PG8_SA(1, 1), a1 + hstep, voffA);
            PG8_WAIT_V(8); PG8_WAIT_L(0); PG8_BAR; PG8_MMA(0, 0, At, B0); PG8_MMA(0, 1, At, B1); PG8_BAR; PG8_SCHED;
            PG8_LDA(At, 0, 1); PG8_STAGE(PG8_SB(0, 0), b2, voffB); PG8_STAGE(PG8_SB(0, 1), b2 + hstepB, voffB); PG8_STAGE(PG8_SA(0, 0), a2, voffA);
            PG8_WAIT_V(8); PG8_WAIT_L(0); PG8_BAR; PG8_MMA(1, 0, At, B0); PG8_MMA(1, 1, At, B1); PG8_BAR; PG8_SCHED;
            PG8_LDB(B0, 1, 0); PG8_LDB(B1, 1, 1); PG8_SCHED; PG8_LDA(At, 1, 0); PG8_STAGE(PG8_SA(0, 1), a2 + hstep, voffA);
            PG8_WAIT_V(8); PG8_WAIT_L(0); PG8_BAR; PG8_MMA(0, 0, At, B0); PG8_MMA(0, 1, At, B1); PG8_BAR; PG8_SCHED;
            PG8_LDA(At, 1, 1); PG8_STAGE(PG8_SB(1, 0), b3, voffB); PG8_STAGE(PG8_SB(1, 1), b3 + hstepB, voffB); PG8_STAGE(PG8_SA(1, 0), a3, voffA);
            PG8_WAIT_V(8); PG8_WAIT_L(0); PG8_BAR; PG8_MMA(1, 0, At, B0); PG8_MMA(1, 1, At, B1); PG8_BAR; PG8_SCHED;
            } else {
            PG8_LDB(B0, 0, 0); PG8_SCHED; PG8_LDA(At, 0, 0); PG8_STAGE(PG8_SA(1, 1), a1 + hstep, voffA);
            PG8_WAIT_L(8); PG8_BAR; PG8_WAIT_L(0); PG8_MMA(0, 0, At, B0); PG8_BAR; PG8_SCHED;
            PG8_LDB(B1, 0, 1); PG8_STAGE(PG8_SB(0, 0), b2, voffB);
            PG8_BAR; PG8_WAIT_L(0); PG8_MMA(0, 1, At, B1); PG8_BAR;
            PG8_LDA(At, 0, 1); PG8_STAGE(PG8_SA(0, 0), a2, voffA);
            PG8_BAR; PG8_WAIT_L(0); PG8_MMA(1, 0, At, B0); PG8_BAR; PG8_SCHED;
            PG8_STAGE(PG8_SB(0, 1), b2 + hstepB, voffB);
            PG8_WAIT_V(6); PG8_BAR; PG8_MMA(1, 1, At, B1); PG8_BAR;
            PG8_LDB(B0, 1, 0); PG8_SCHED; PG8_LDA(At, 1, 0); PG8_STAGE(PG8_SA(0, 1), a2 + hstep, voffA);
            PG8_WAIT_L(8); PG8_BAR; PG8_WAIT_L(0); PG8_MMA(0, 0, At, B0); PG8_BAR; PG8_SCHED;
            PG8_LDB(B1, 1, 1); PG8_STAGE(PG8_SB(1, 0), b3, voffB);
            PG8_BAR; PG8_WAIT_L(0); PG8_MMA(0, 1, At, B1); PG8_BAR;
            PG8_LDA(At, 1, 1); PG8_STAGE(PG8_SA(1, 0), a3, voffA);
            PG8_BAR; PG8_WAIT_L(0); PG8_MMA(1, 0, At, B0); PG8_BAR; PG8_SCHED;
            PG8_STAGE(PG8_SB(1, 1), b3 + hstepB, voffB);
            PG8_WAIT_V(6); PG8_BAR; PG8_MMA(1, 1, At, B1); PG8_BAR;
            }
        }
        if constexpr (ALIGN_EPI) { if (wr == 0) PG8_BAR; }
        if constexpr (!Epi::AFTER_DRAIN) { E(acc, cur, wr, wc, fr, fq); S.done(cur); }
        if (!has_next) break;
#pragma unroll
        for (int a = 0; a < 2; ++a)
#pragma unroll
            for (int b = 0; b < 2; ++b)
#pragma unroll
                for (int m = 0; m < 4; ++m)
#pragma unroll
                    for (int n = 0; n < 2; ++n) acc[a][b][m][n] = (f32x4){0.f, 0.f, 0.f, 0.f};
        cur = nxt; cA = nA; cB = nB; ++ui;
        if constexpr (ALIGN_EPI) { if (wr == 1) PG8_BAR; }
    }
    PG8_WAIT_V(0);
    if constexpr (!ALIGN_EPI) { if (wr == 0) PG8_BAR; }
    PG8_BAR;
    if constexpr (Epi::AFTER_DRAIN) { E.fused(acc, cur, wr, wc, fr, fq, lds, wid, lane); S.done(cur); }
#undef PG8_SA
#undef PG8_SB
#undef PG8_STAGE
#undef PG8_LDA
#undef PG8_LDB
#undef PG8_MMA
#undef PG8_WAIT_V
#undef PG8_WAIT_L
#undef PG8_BAR
#undef PG8_SCHED
}
}


#define GAS __attribute__((address_space(1)))
#define LAS __attribute__((address_space(3)))
typedef unsigned short bf16;
typedef float f32x4 __attribute__((ext_vector_type(4)));
typedef short bf16x8 __attribute__((ext_vector_type(8)));
typedef short s16x4 __attribute__((ext_vector_type(4)));
typedef unsigned u32x4 __attribute__((ext_vector_type(4)));
typedef unsigned u32x2 __attribute__((ext_vector_type(2)));
constexpr int DM = 2048, DFF = 3072, SEQ = 16384, NB = 2, NP = NB * SEQ, DBAT = 32, DSEQ = 16, NS = DBAT * DSEQ, MR = NP + NS;
constexpr int NMEM = 256, NMR = NB * NMEM, MRX = MR + NMR;
constexpr int QKVW = 3584, AOW = 1536, INW = 4608, TOKW = 1024, MEMW = 512;
constexpr int PAST = 1024, ACACHE = 512, NLAYER = 4;
constexpr float EPS = 1e-6f;
constexpr int NPH = 1 + 7 * NLAYER;
constexpr size_t O_Y = 0, O_AKP = (size_t)MR * DM, O_AVP = O_AKP + 2097152, O_BKP = O_AVP + 2097152, O_BVP = O_BKP + 67108864, O_MKP = O_BVP + 67108864,
                 O_MVP = O_MKP + 1048576, O_AKS = O_MVP + 1048576, O_AVS = O_AKS + 1048576, O_BKS = O_AVS + 1048576, O_BVS = O_BKS + 1048576, O_END = O_BVS + 1048576;
static_assert(O_END == 212860928, "output size");
constexpr size_t MiB = 1u << 20;
constexpr size_t WS_CTL = 0, CTL_ZERO_BYTES = 1 * MiB;
constexpr size_t LW_1U = 0, LW_1D = LW_1U + (size_t)2 * DFF * DM * 2, LW_IN = LW_1D + (size_t)DM * DFF * 2, LW_O = LW_IN + (size_t)INW * DM * 2, LW_2U = LW_O + (size_t)DM * AOW * 2,
                 LW_2D = LW_2U + (size_t)2 * DFF * DM * 2, LW_SIZE = LW_2D + (size_t)DM * DFF * 2;
static_assert(LW_SIZE == 96 * MiB, "per-layer weight bytes");
constexpr size_t WS_W = 1 * MiB, WS_XB = WS_W + NLAYER * LW_SIZE, WS_H = WS_XB + 132 * MiB, WS_QKV = WS_H + 195 * MiB, WS_AO = WS_QKV + 228 * MiB, WS_MKV = WS_AO + 98 * MiB,
                 WS_SSQ = WS_MKV + 4 * MiB, WS_DBG = WS_SSQ + 3 * MiB, WS_END = WS_DBG + 1 * MiB;
static_assert((size_t)MRX * DM * 2 <= 132 * MiB && (size_t)MR * DFF * 2 <= 195 * MiB && (size_t)MR * QKVW * 2 <= 228 * MiB && (size_t)MR * AOW * 2 <= 98 * MiB, "ws map");
constexpr size_t SSQ_BUF = (size_t)MR * 8;
constexpr int RING_BYTES = 131072, TAB1_OFF = 131072  , TAB2_OFF = 135168  , MISC_OFF = 143360, TAB3_OFF = 147456  , LDS_BYTES = 155648;
constexpr int VT_STRIDE = 17408;
static_assert(8 * VT_STRIDE <= MISC_OFF, "lds map");

#define RLX_AGENT __ATOMIC_RELAXED, __HIP_MEMORY_SCOPE_AGENT
#define LDS_WAIT() asm volatile("s_waitcnt lgkmcnt(0)" ::: "memory")
#define VM_WAIT() asm volatile("s_waitcnt vmcnt(0)" ::: "memory")
__device__ __forceinline__ unsigned pkbf(float lo, float hi) { typedef float f2 __attribute__((ext_vector_type(2))); typedef __bf16 b2 __attribute__((ext_vector_type(2))); f2 v = {lo, hi}; b2 b = __builtin_convertvector(v, b2); return __builtin_bit_cast(unsigned, b); }
__device__ __forceinline__ void st16_wt(const __amdgpu_buffer_rsrc_t r, unsigned off, u32x4 v) { __builtin_amdgcn_raw_buffer_store_b128(v, r, off, 0,   16); }
__device__ __forceinline__ float fexp(float x) { return __builtin_amdgcn_exp2f(x * 1.4426950408889634f); }
__device__ __forceinline__ float flog(float x) { return __builtin_amdgcn_logf(x) * 0.6931471805599453f; }
__device__ __forceinline__ float dot4(f32x4 a) { return (a.x * a.x + a.y * a.y) + (a.z * a.z + a.w * a.w); }
__device__ __forceinline__ float row_rscale(const float* ssq, int row) {
    const f32x4 a = *(const f32x4*)(ssq + (size_t)row * 8), b = *(const f32x4*)(ssq + (size_t)row * 8 + 4);
    return __builtin_amdgcn_rsqf(((a.x + a.y) + (a.z + a.w) + (b.x + b.y) + (b.z + b.w)) * (1.0f / DM) + EPS);
}
#define EPI_BAR() do { asm volatile("s_waitcnt lgkmcnt(0)" ::: "memory"); __builtin_amdgcn_s_barrier(); asm volatile("" ::: "memory"); } while (0)

typedef pg8::f32x4 acc_t[2][2][4][2];

struct EpiSwiGLU {
    static constexpr bool PERM = true, AFTER_DRAIN = false, ADJ = false, PREFETCH = true;
    bf16* H; const float* ssq; LAS float* tabs;
    __device__ __forceinline__ void prefetch(const pg8::Unit& u, LAS unsigned char* lds, int tid, int wid) const {
        __builtin_amdgcn_global_load_lds((const unsigned*)(ssq + (size_t)(u.pm * 256) * 8 + tid * 4), (LAS unsigned*)(lds + TAB2_OFF + wid * 1024), 16, 0, 0);
    }
    __device__ __forceinline__ void operator()(const acc_t& acc, const pg8::Unit& u, int wr, int wc, int fr, int fq) const {
        const int row0 = u.pm * 256 + wr * 64 + fr, col0 = u.pn * 128 + wc * 32 + 8 * fq;
        const __amdgpu_buffer_rsrc_t hr = __builtin_amdgcn_make_buffer_rsrc((void*)H, 0, (int)((size_t)MR * DFF * 2), 0x00020000);
        f32x4 pa[2][4], pb[2][4]; float rs[2][4];
#pragma unroll
        for (int ai = 0; ai < 2; ++ai)
#pragma unroll
            for (int m = 0; m < 4; ++m) { const LAS float* sp = tabs + (wr * 64 + fr + ai * 128 + m * 16) * 8; pa[ai][m] = *(const LAS f32x4*)sp; pb[ai][m] = *(const LAS f32x4*)(sp + 4); }
#pragma unroll
        for (int ai = 0; ai < 2; ++ai)
#pragma unroll
            for (int m = 0; m < 4; ++m) { const f32x4 a4 = pa[ai][m], b4 = pb[ai][m]; rs[ai][m] = __builtin_amdgcn_rsqf(((a4.x + a4.y) + (a4.z + a4.w) + (b4.x + b4.y) + (b4.z + b4.w)) * (1.0f / DM) + EPS); }
#pragma unroll
        for (int ai = 0; ai < 2; ++ai)
#pragma unroll
            for (int m = 0; m < 4; ++m) {
                const int row = row0 + ai * 128 + m * 16; const float r = rs[ai][m];
                float hv[8];
#pragma unroll
                for (int n = 0; n < 2; ++n)
#pragma unroll
                    for (int e = 0; e < 4; ++e) { const float a = acc[ai][0][m][n][e] * r, b = acc[ai][1][m][n][e] * r;
                        hv[n * 4 + e] = a * __builtin_amdgcn_rcpf(1.0f + fexp(-a)) * b; }
                u32x4 w; w.x = pkbf(hv[0], hv[1]); w.y = pkbf(hv[2], hv[3]); w.z = pkbf(hv[4], hv[5]); w.w = pkbf(hv[6], hv[7]);
                st16_wt(hr, (unsigned)((size_t)(row - fr) * DFF * 2 + (size_t)(fr & 7) * (2 * DFF * 2) + (u.pn * 4 + wc) * 128 + (fr >> 3) * 64 + fq * 16), w);
            }
    }
};

struct EpiResid {
    static constexpr bool PERM = true, AFTER_DRAIN = false, ADJ = true, PREFETCH = false;
    bf16* xb; float* outf; float* ssq_out; LAS float* tab;
    __device__ __forceinline__ void operator()(const acc_t& acc, const pg8::Unit& u, int wr, int wc, int fr, int fq) const {
        const int rl0 = wr * 64 + fr, row0 = u.pm * 256 + rl0, col0 = u.pn * 256 + wc * 64 + 8 * fq;
        const __amdgpu_buffer_rsrc_t xr = __builtin_amdgcn_make_buffer_rsrc((void*)xb, 0, (int)((size_t)MR * DM * 2), 0x00020000);
        const bool lower = fr < 8;
        const size_t lbase = ((size_t)(u.pm * 256 + wr * 64 + (fr & 7)) * DM + u.pn * 256) * 2 + (size_t)(wc * 128 + (lower ? 0 : 64) + fq * 16);
        u32x4 xpre[2][4][2];
#pragma unroll
        for (int ai = 0; ai < 2; ++ai)
#pragma unroll
            for (int m = 0; m < 4; ++m)
#pragma unroll
                for (int bj = 0; bj < 2; ++bj) xpre[ai][m][bj] = *(const u32x4*)((const char*)xb + lbase + (size_t)((ai * 128 + m * 16 + 8 * bj) * DM * 2));
        asm volatile("" : "+v"(xpre[0][0][0]), "+v"(xpre[0][1][0]), "+v"(xpre[0][2][0]), "+v"(xpre[0][3][0]), "+v"(xpre[1][0][0]), "+v"(xpre[1][1][0]), "+v"(xpre[1][2][0]), "+v"(xpre[1][3][0]) :: "memory");
        asm volatile("" : "+v"(xpre[0][0][1]), "+v"(xpre[0][1][1]), "+v"(xpre[0][2][1]), "+v"(xpre[0][3][1]), "+v"(xpre[1][0][1]), "+v"(xpre[1][1][1]), "+v"(xpre[1][2][1]), "+v"(xpre[1][3][1]) :: "memory");
        const unsigned sbase = (unsigned)lbase;
#pragma unroll
        for (int ai = 0; ai < 2; ++ai)
#pragma unroll
            for (int m = 0; m < 4; ++m) {
                const int row = row0 + ai * 128 + m * 16; float sq = 0.f;
                u32x4 w[2], xo[2];
                {
                    const u32x4 la = xpre[ai][m][0], lb = xpre[ai][m][1]; u32x4 ls, lr;
                    ls.x = lower ? lb.x : la.x; ls.y = lower ? lb.y : la.y; ls.z = lower ? lb.z : la.z; ls.w = lower ? lb.w : la.w;
                    lr.x = (unsigned)__builtin_amdgcn_mov_dpp((int)ls.x, 0x128, 0xf, 0xf, false); lr.y = (unsigned)__builtin_amdgcn_mov_dpp((int)ls.y, 0x128, 0xf, 0xf, false);
                    lr.z = (unsigned)__builtin_amdgcn_mov_dpp((int)ls.z, 0x128, 0xf, 0xf, false); lr.w = (unsigned)__builtin_amdgcn_mov_dpp((int)ls.w, 0x128, 0xf, 0xf, false);
                    xo[0].x = lower ? la.x : lr.x; xo[0].y = lower ? la.y : lr.y; xo[0].z = lower ? la.z : lr.z; xo[0].w = lower ? la.w : lr.w;
                    xo[1].x = lower ? lr.x : lb.x; xo[1].y = lower ? lr.y : lb.y; xo[1].z = lower ? lr.z : lb.z; xo[1].w = lower ? lr.w : lb.w;
                }
#pragma unroll
                for (int bj = 0; bj < 2; ++bj) {
                    const size_t o = (size_t)row * DM + col0 + bj * 32;
                    const u32x4 xin = xo[bj];
                    f32x4 x0, x1;
                    x0.x = __uint_as_float(xin.x << 16); x0.y = __uint_as_float(xin.x & 0xffff0000u); x0.z = __uint_as_float(xin.y << 16); x0.w = __uint_as_float(xin.y & 0xffff0000u);
                    x1.x = __uint_as_float(xin.z << 16); x1.y = __uint_as_float(xin.z & 0xffff0000u); x1.z = __uint_as_float(xin.w << 16); x1.w = __uint_as_float(xin.w & 0xffff0000u);
                    const f32x4 v0 = x0 + acc[ai][bj][m][0], v1 = x1 + acc[ai][bj][m][1];
                    if (outf) { *(f32x4*)(outf + o) = v0; *(f32x4*)(outf + o + 4) = v1; }
                    w[bj].x = pkbf(v0.x, v0.y); w[bj].y = pkbf(v0.z, v0.w); w[bj].z = pkbf(v1.x, v1.y); w[bj].w = pkbf(v1.z, v1.w);
                    sq += dot4(v0) + dot4(v1);
                }
                if (outf) continue;
                u32x4 xs, yr;
                xs.x = lower ? w[1].x : w[0].x; xs.y = lower ? w[1].y : w[0].y; xs.z = lower ? w[1].z : w[0].z; xs.w = lower ? w[1].w : w[0].w;
                yr.x = (unsigned)__builtin_amdgcn_mov_dpp((int)xs.x, 0x128, 0xf, 0xf, false); yr.y = (unsigned)__builtin_amdgcn_mov_dpp((int)xs.y, 0x128, 0xf, 0xf, false);
                yr.z = (unsigned)__builtin_amdgcn_mov_dpp((int)xs.z, 0x128, 0xf, 0xf, false); yr.w = (unsigned)__builtin_amdgcn_mov_dpp((int)xs.w, 0x128, 0xf, 0xf, false);
                u32x4 dA, dB;
                dA.x = lower ? w[0].x : yr.x; dA.y = lower ? w[0].y : yr.y; dA.z = lower ? w[0].z : yr.z; dA.w = lower ? w[0].w : yr.w;
                dB.x = lower ? yr.x : w[1].x; dB.y = lower ? yr.y : w[1].y; dB.z = lower ? yr.z : w[1].z; dB.w = lower ? yr.w : w[1].w;
                const unsigned so = sbase + (unsigned)((ai * 128 + m * 16) * DM * 2);
                st16_wt(xr, so, dA); st16_wt(xr, so + (unsigned)(8 * DM * 2), dB);
                sq += __shfl_xor(sq, 16); sq += __shfl_xor(sq, 32);
                if (fq == 0) tab[(rl0 + ai * 128 + m * 16) * 4 + wc] = sq;
            }
        if (outf) return;
        EPI_BAR();
#pragma unroll
        for (int t = 0; t < 2; ++t) { const int g = wc * 2 + t, rl = (g >> 2) * 128 + (g & 3) * 16 + rl0;
            if (fq == 0) { const f32x4 p = *(const LAS f32x4*)(tab + rl * 4); __hip_atomic_store(ssq_out + (size_t)(u.pm * 256 + rl) * 8 + u.pn, (p.x + p.y) + (p.z + p.w), RLX_AGENT); } }
    }
};

struct EpiQKV {
    static constexpr bool PERM = true, AFTER_DRAIN = false, ADJ = false, PREFETCH = true;
    bf16* QKV; bf16* MKV; const float* ssq; const float* gains;
    float* out; int l;
    LAS float* tab2; LAS float* tabs;
    __device__ __forceinline__ void prefetch(const pg8::Unit& u, LAS unsigned char* lds, int tid, int wid) const {
        const int r0 = u.pm >= MR / 256 ? 0 : u.pm * 256;
        __builtin_amdgcn_global_load_lds((const unsigned*)(ssq + (size_t)r0 * 8 + tid * 4), (LAS unsigned*)(lds + TAB3_OFF + wid * 1024), 16, 0, 0);
    }
    __device__ __forceinline__ void operator()(const acc_t& acc, const pg8::Unit& u, int wr, int wc, int fr, int fq) const {
        const int pm = u.pm, pn = u.pn; const bool memrow = pm >= MR / 256; const int layerB = l & 1, j = l >> 1;
        const int rl0 = wr * 64 + fr, row0 = pm * 256 + rl0, cw = wc * 32 + 8 * fq;
        const int kind = memrow ? (pn < 16 ? 4 : 5) : (pn < 4 ? 0 : pn < 8 ? 1 : pn < 12 ? 2 : 3);
        const bool need_norm = (kind == 3) || (kind == 4) || (!layerB && kind <= 1);
        acc_t& va = const_cast<acc_t&>(acc);
#define VQ(ai, bj, m, e) va[ai][bj][m][(e) >> 2][(e) & 3]
        int zo = 0;
        f32x4 pa[2][4], pb[2][4];
#pragma unroll
        for (int ai = 0; ai < 2; ++ai)
#pragma unroll
            for (int m = 0; m < 4; ++m) { const LAS float* sp = tabs + (rl0 + ai * 128 + m * 16) * 8; pa[ai][m] = *(const LAS f32x4*)sp; pb[ai][m] = *(const LAS f32x4*)(sp + 4); }
        float sq[2][4][2];
#pragma unroll
        for (int ai = 0; ai < 2; ++ai)
#pragma unroll
            for (int m = 0; m < 4; ++m) {
                const f32x4 a4 = pa[ai][m], b4 = pb[ai][m];
                float r = __builtin_amdgcn_rsqf(((a4.x + a4.y) + (a4.z + a4.w) + (b4.x + b4.y) + (b4.z + b4.w)) * (1.0f / DM) + EPS);
                r = memrow ? 1.0f : r;
#pragma unroll
                for (int bj = 0; bj < 2; ++bj) {
#pragma unroll
                    for (int n = 0; n < 2; ++n) va[ai][bj][m][n] *= r;
                    sq[ai][m][bj] = dot4(va[ai][bj][m][0]) + dot4(va[ai][bj][m][1]);
                }
            }
        if (need_norm) {
#pragma unroll
            for (int ai = 0; ai < 2; ++ai)
#pragma unroll
                for (int m = 0; m < 4; ++m)
#pragma unroll
                    for (int bj = 0; bj < 2; ++bj) sq[ai][m][bj] += __shfl_xor(sq[ai][m][bj], 16);
#pragma unroll
            for (int ai = 0; ai < 2; ++ai)
#pragma unroll
                for (int m = 0; m < 4; ++m)
#pragma unroll
                    for (int bj = 0; bj < 2; ++bj) sq[ai][m][bj] += __shfl_xor(sq[ai][m][bj], 32);
            if (fq == 0) {
#pragma unroll
                for (int ai = 0; ai < 2; ++ai)
#pragma unroll
                    for (int m = 0; m < 4; ++m)
#pragma unroll
                        for (int bj = 0; bj < 2; ++bj) tab2[((rl0 + ai * 128 + m * 16) * 2 + bj) * 4 + wc] = sq[ai][m][bj];
            }
        }
        float g[8];
        if (need_norm) {
            EPI_BAR();
            const float* gp = gains + ((kind == 0) ? 0 : (kind == 1) ? 128 : (kind == 3) ? 256 : 384);
            const float post = (kind == 0 || kind == 3) ? 0.08838834764831845f : 1.0f;
#pragma unroll
            for (int e = 0; e < 8; ++e) g[e] = gp[cw + e] * post;
        } else {
            const float post = (kind == 0) ? 0.0625f : 1.0f;
#pragma unroll
            for (int e = 0; e < 8; ++e) g[e] = post;
        }
        float* fo = nullptr; int fpitch = TOKW;
        const int ct = (kind == 1) ? (pn - 4) * 256 : (kind == 2) ? (pn - 8) * 256 : (kind == 4) ? (pn - 14) * 256 : (kind == 5) ? (pn - 16) * 256 : 0;
        if (kind == 1 || kind == 2) {
            const bool isk = kind == 1;
            if (pm >= NP / 256) fo = out + (layerB ? (isk ? O_BKS : O_BVS) : (isk ? O_AKS : O_AVS)) + (size_t)j * NS * TOKW + (size_t)(pm * 256 - NP) * TOKW;
            else if (layerB) fo = out + (isk ? O_BKP : O_BVP) + (size_t)j * NP * TOKW + (size_t)(pm * 256) * TOKW;
            else if ((pm & 63) >= 62) fo = out + (isk ? O_AKP : O_AVP) + (size_t)j * NB * 512 * TOKW + (size_t)((pm >> 6) * 512 + ((pm & 63) - 62) * 256) * TOKW;
        } else if (kind >= 4) { fo = out + (kind == 4 ? O_MKP : O_MVP) + (size_t)l * NMR * MEMW + (size_t)(pm * 256 - MR) * MEMW; fpitch = MEMW; }
        if (fo) fo += ct + cw;
        bf16* bo = memrow ? MKV + (size_t)(pm * 256 - MR) * 1024 + (pn - 14) * 256 + cw : QKV + (size_t)(pm * 256) * QKVW + pn * 256 + cw;
        const int bpitch = memrow ? 1024 : QKVW;
        const __amdgpu_buffer_rsrc_t br = __builtin_amdgcn_make_buffer_rsrc((void*)(memrow ? MKV : QKV), 0, memrow ? (int)((size_t)NMR * 1024 * 2) : (int)((size_t)MR * QKVW * 2), 0x00020000);
        const unsigned bo0 = (unsigned)((const char*)bo - (const char*)(memrow ? MKV : QKV));
#pragma unroll
        for (int ai = 0; ai < 2; ++ai)
#pragma unroll
            for (int m = 0; m < 4; ++m) {
                asm volatile("" : "+s"(zo) :: "memory");
                const int rl = rl0 + ai * 128 + m * 16 + zo;
#pragma unroll
                for (int bj = 0; bj < 2; ++bj) {
                    float rn = 1.0f;
                    if (need_norm) { const f32x4 p = *(const LAS f32x4*)(tab2 + (rl * 2 + bj) * 4); rn = __builtin_amdgcn_rsqf(((p.x + p.y) + (p.z + p.w)) * (1.0f / 128.0f) + EPS); }
#pragma unroll
                    for (int e = 0; e < 8; ++e) VQ(ai, bj, m, e) *= rn * g[e];
                    const f32x4 x0 = va[ai][bj][m][0], x1 = va[ai][bj][m][1];
                    u32x4 w; w.x = pkbf(x0.x, x0.y); w.y = pkbf(x0.z, x0.w); w.z = pkbf(x1.x, x1.y); w.w = pkbf(x1.z, x1.w);
                    st16_wt(br, bo0 + (unsigned)((rl * bpitch + bj * 128) * 2), w);
                    if (fo) { float* p = fo + (size_t)rl * fpitch + bj * 128; *(f32x4*)p = x0; *(f32x4*)(p + 4) = x1; }
                }
            }
    }
};
#undef VQ
__device__ __forceinline__ void unit_map(int L, int nM, int nN, pg8::Unit& u) {
    const int nwg = nM * nN; int wgid = L; { const int q = nwg / 8, r = nwg % 8, xcd = wgid % 8, off = wgid / 8; wgid = (xcd < r ? xcd * (q + 1) : r * (q + 1) + (xcd - r) * q) + off; }
    const int nig = 8 * nN, gid = wgid / nig, fm = gid * 8, gsz = (nM - fm) < 8 ? (nM - fm) : 8;
    u.pm = fm + ((wgid % nig) % gsz); u.pn = (wgid % nig) / gsz;
}
struct XcdDeal {
    int nN, x, r, k0, n, lbase;
    __device__ __forceinline__ void init(int nN_, int T, int c, int& base) { nN = nN_; x = c & 7; r = c >> 3; n = 16 * nN_ + (T - x + 7) / 8; const int d = base - r; k0 = d > 0 ? (d + 31) >> 5 : 0; lbase = base; base += n; }
    __device__ __forceinline__ bool next(int i, pg8::Unit& u) const {
        const int loc = r + 32 * (k0 + i) - lbase; if (loc >= n) return false;
        if (loc < 16 * nN) { const int g8 = loc >= 8 * nN, w = loc - g8 * 8 * nN; u.pm = x + 8 * (g8 * 8 + (w & 7)); u.pn = w >> 3; return true; }
        const int t = (loc - 16 * nN) * 8 + x;
        if (t < 2 * nN) { u.pm = NP / 256 + (t & 1); u.pn = t >> 1; } else { const int m = t - 2 * nN; u.pm = MR / 256 + (m >> 2); u.pn = 14 + (m & 3); }
        return true;
    }
    __device__ __forceinline__ void a_ready(const pg8::Unit&) const {}
    __device__ __forceinline__ void done(const pg8::Unit&) const {}
};
struct DynDeal {
    int nN, T, x, w0; unsigned* ctr; mutable int par;
    __device__ __forceinline__ bool next(int, pg8::Unit& u) const {
        volatile LAS unsigned* slot = (volatile LAS unsigned*)(unsigned)(MISC_OFF + 104);
        if (w0) {
            if (__builtin_amdgcn_mbcnt_hi(~0u, __builtin_amdgcn_mbcnt_lo(~0u, 0u)) == 0u) {
                unsigned code = 0u;
                for (int v = 0; v < 8; ++v) {
                    const int xv = (x + v) & 7; const unsigned nv = 16u * nN + (unsigned)(T - xv + 7) / 8u;
                    const unsigned e = __hip_atomic_fetch_add(ctr + 16 * xv, 1u, RLX_AGENT);
                    if (e < nv) { code = (((unsigned)xv << 16) | e) + 1u; break; }
                }
                slot[par] = code;
            }
            asm volatile("s_waitcnt lgkmcnt(0)" ::: "memory");
        }
        asm volatile("" ::: "memory"); __builtin_amdgcn_s_barrier(); asm volatile("" ::: "memory");
        const unsigned code = (unsigned)__builtin_amdgcn_readfirstlane(slot[par]); par ^= 1;
        if (code == 0u) return false;
        const int xv = (int)((code - 1u) >> 16), loc = (int)((code - 1u) & 0xffffu);
        if (loc < 16 * nN) { const int g8 = loc >= 8 * nN, w = loc - g8 * 8 * nN; u.pm = xv + 8 * (g8 * 8 + (w & 7)); u.pn = w >> 3; return true; }
        const int t = (loc - 16 * nN) * 8 + xv;
        if (t < 2 * nN) { u.pm = NP / 256 + (t & 1); u.pn = t >> 1; } else { const int m = t - 2 * nN; u.pm = MR / 256 + (m >> 2); u.pn = 14 + (m & 3); }
        return true;
    }
    __device__ __forceinline__ void a_ready(const pg8::Unit&) const {}
    __device__ __forceinline__ void done(const pg8::Unit&) const {}
};
constexpr int PC_WORD0 = 131072, PC_STRIDE = 16, DC_WORD0 = 180224, BC_WORD0 = 184320;
struct Gate { const unsigned* wctr; unsigned need; unsigned* pctr; unsigned* tmo; int w0; int bmode = 0; };
template <class Base> struct Gated : Base {
    Gate g; mutable int rdy;
    __device__ __forceinline__ void a_ready(const pg8::Unit& u) const {
        if (g.wctr == nullptr || u.pm == rdy || u.pm >= MR / 256) return;
        rdy = u.pm;
        if (g.w0) {
            const unsigned* p = g.wctr + PC_STRIDE * u.pm;
            unsigned polls = 0;
            while ((unsigned)__builtin_amdgcn_readfirstlane(__hip_atomic_load(p, RLX_AGENT)) < g.need) {
                if ((++polls & 255u) == 0u) {
                    if (__builtin_amdgcn_readfirstlane(__hip_atomic_load(g.tmo, RLX_AGENT)) != 0u) break;
                    if (polls > (1u << 18)) { __hip_atomic_store(g.tmo, 1u, RLX_AGENT); break; }
                }
                __builtin_amdgcn_s_sleep(2);
            }
            __builtin_amdgcn_fence(__ATOMIC_ACQUIRE, "agent");
            asm volatile("s_waitcnt vmcnt(0)" ::: "memory");
        }
        asm volatile("" ::: "memory"); __builtin_amdgcn_s_barrier(); asm volatile("" ::: "memory");
    }
    __device__ __forceinline__ void done(const pg8::Unit& u) const {
        if (g.pctr == nullptr) return;
        asm volatile("s_waitcnt vmcnt(0)" ::: "memory");
        if (__builtin_amdgcn_mbcnt_hi(~0u, __builtin_amdgcn_mbcnt_lo(~0u, 0u)) == 0u) __hip_atomic_fetch_add(g.pctr + PC_STRIDE * (g.bmode ? (u.pm < 64 ? 0 : u.pm < 128 ? 1 : u.pm < MR / 256 ? 2 : 3) : u.pm), 1u, RLX_AGENT);
    }
};
#define XB_TMO      128
#define XB_XCNT(j)  (256  + 64 * (j))
#define XB_XSUB(j)  (1280 + 64 * (j))
#define XB_XGEN(j)  (2304 + 64 * (j))
#define XB_TOP      3328
#define XB_TOPGEN   3392
#define XCD_BAR_WORDS 3456
#define XB_SPIN_CAP (1u << 18)

__device__ __forceinline__ unsigned xb_ld(unsigned* p)              { return __hip_atomic_load(p, __ATOMIC_RELAXED, __HIP_MEMORY_SCOPE_AGENT); }
__device__ __forceinline__ unsigned xb_add(unsigned* p, unsigned v) { return __hip_atomic_fetch_add(p, v, __ATOMIC_RELAXED, __HIP_MEMORY_SCOPE_AGENT); }
__device__ __forceinline__ unsigned xb_xcc_id() { return (unsigned)__builtin_amdgcn_s_getreg((3 << 11) | 20) & 0xFu; }
#define XB_SPIN(cond, bar) do { unsigned _sp = 0; while (cond) { __builtin_amdgcn_s_sleep(1); \
    if ((++_sp & 255u) == 0u) { if (xb_ld(&(bar)[XB_TMO])) break; if (_sp > XB_SPIN_CAP) { atomicAdd(&(bar)[XB_TMO], 1u); break; } } } } while (0)

struct XcdBarrier {
    unsigned total;
    unsigned* bar; unsigned x;
    volatile LAS unsigned* st;
};

__device__ __forceinline__ XcdBarrier xcd_barrier_post(unsigned* bar, volatile LAS unsigned* st) {
    XcdBarrier b; b.total = 0u; b.bar = bar; b.x = xb_xcc_id(); b.st = st;
    if (threadIdx.x == 0) (void)xb_add(&bar[XB_XCNT(b.x)], 1u);
    return b;
}
__device__ __forceinline__ void xcd_barrier_complete(unsigned* bar, unsigned x, unsigned& nloc, unsigned& nx, unsigned total) {
    const unsigned G = total ? total : gridDim.x * gridDim.y * gridDim.z;
    unsigned sum, cnt, mine, sp = 0u;
    for (;;) {
        sum = 0u; cnt = 0u; mine = 0u;
#pragma unroll
        for (unsigned j = 0; j < 16; ++j) { const unsigned c = xb_ld(&bar[XB_XCNT(j)]); sum += c; cnt += (c > 0u) ? 1u : 0u; mine = (j == x) ? c : mine; }
        if (sum == G) break;
        __builtin_amdgcn_s_sleep(1);
        if ((++sp & 255u) == 0u) { if (xb_ld(&bar[XB_TMO])) break; if (sp > XB_SPIN_CAP) { atomicAdd(&bar[XB_TMO], 1u); break; } }
    }
    nloc = mine > 0u ? mine : 1u; nx = cnt > 0u ? cnt : 1u;
}

__device__ __forceinline__ void xcd_barrier(const XcdBarrier& b) {
    asm volatile("s_waitcnt vmcnt(0)" ::: "memory");
    __syncthreads();
    if (threadIdx.x == 0) {
        unsigned* bar = b.bar;
        __builtin_amdgcn_s_waitcnt(0);
        unsigned nloc = b.st[0], nx = b.st[1];
        if (nloc == 0u) { xcd_barrier_complete(bar, b.x, nloc, nx, b.total); b.st[0] = nloc; b.st[1] = nx; }
        const unsigned old = xb_add(&bar[XB_XSUB(b.x)], 1u);
        const unsigned gen = old / nloc;
        if (old + 1u == (gen + 1u) * nloc) {
            __builtin_amdgcn_fence(__ATOMIC_RELEASE, "agent");
            asm volatile("s_waitcnt vmcnt(0)" ::: "memory");
            const unsigned og = xb_add(&bar[XB_TOP], 1u);
            const unsigned tg = og / nx;
            if (og + 1u == (tg + 1u) * nx) xb_add(&bar[XB_TOPGEN], 1u);
            else XB_SPIN(xb_ld(&bar[XB_TOPGEN]) == tg, bar);
            __builtin_amdgcn_fence(__ATOMIC_ACQUIRE, "agent");
            xb_add(&bar[XB_XGEN(b.x)], 1u);
            asm volatile("s_waitcnt vmcnt(0)" ::: "memory");
        } else {
            XB_SPIN(xb_ld(&bar[XB_XGEN(b.x)]) == gen, bar);
            __builtin_amdgcn_fence(__ATOMIC_ACQUIRE, "agent");
            asm volatile("s_waitcnt vmcnt(0)" ::: "memory");
        }
    }
    __syncthreads();
}


namespace att {
#define MFMA16(a, b, c) __builtin_amdgcn_mfma_f32_16x16x32_bf16((a), (b), (c), 0, 0, 0)
typedef short v4i16_t __attribute__((ext_vector_type(4)));
__device__ __forceinline__ s16x4 vtr(const LAS char* p) { return __builtin_bit_cast(s16x4, __builtin_amdgcn_ds_read_tr16_b64_v4i16((LAS v4i16_t*)p)); }

template <bool F32> __device__ __forceinline__ bf16x8 ld8(const char* rowp, int col) {
    if constexpr (F32) { const f32x4 a = *(const f32x4*)(rowp + (size_t)col * 4), b = *(const f32x4*)(rowp + (size_t)col * 4 + 16);
        u32x4 w; w.x = pkbf(a.x, a.y); w.y = pkbf(a.z, a.w); w.z = pkbf(b.x, b.y); w.w = pkbf(b.z, b.w); return __builtin_bit_cast(bf16x8, w); }
    else return *(const bf16x8*)(rowp + (size_t)col * 2);
}
template <int HD, int QB> __device__ __forceinline__ void load_q(bf16x8 (&qf)[QB][HD / 32], const bf16* q  , int fr, int fq) {
#pragma unroll
    for (int qb = 0; qb < QB; ++qb)
#pragma unroll
        for (int ks = 0; ks < HD / 32; ++ks) qf[qb][ks] = *(const bf16x8*)(q + (size_t)(16 * qb + fr) * QKVW + 32 * ks + 8 * fq);
}
template <int HD, int QB, bool F32> __device__ __forceinline__ void qk_tile(f32x4 (&s)[2][QB], const bf16x8 (&qf)[QB][HD / 32], const char* kbase, size_t pitchB, int key0, int kmax, int fr, int fq) {
#pragma unroll
    for (int u = 0; u < 2; ++u) {
        int row = key0 + 16 * u + fr; row = row < kmax ? row : kmax;
        const char* rp = kbase + (size_t)row * pitchB;
        bf16x8 kf[HD / 32];
#pragma unroll
        for (int ks = 0; ks < HD / 32; ++ks) kf[ks] = ld8<F32>(rp, 32 * ks + 8 * fq);
#pragma unroll
        for (int qb = 0; qb < QB; ++qb) { f32x4 a = {0.f, 0.f, 0.f, 0.f};
#pragma unroll
            for (int ks = 0; ks < HD / 32; ++ks) a = MFMA16(kf[ks], qf[qb][ks], a);
            s[u][qb] = a; }
    }
}
template <int HD, bool F32> __device__ __forceinline__ void stage_v(LAS char* vt, const char* vbase, size_t pitchB, int key0, int kmax, int lane) {
    constexpr int CPR = HD / 8, PITCH = HD * 2 + 32;
#pragma unroll
    for (int i = 0; i < 32 * CPR / 64; ++i) { const int n = lane + 64 * i, row = n / CPR, ch = n % CPR; int grow = key0 + row; grow = grow < kmax ? grow : kmax;
        const bf16x8 v = ld8<F32>(vbase + (size_t)grow * pitchB, ch * 8);
        *(LAS bf16x8*)(vt + row * PITCH + ch * 16) = v; }
}
template <int HD, int QB, int PITCH = HD * 2 + 32> __device__ __forceinline__ void pv_tile(f32x4 (&o)[HD / 16][QB], const bf16x8 (&pf)[QB], const LAS char* vt, int lane) {
    const int fq = lane >> 4, q = (lane & 15) >> 2, p = lane & 3;
    const LAS char* base = vt + (4 * fq + q) * PITCH + p * 8;
#pragma unroll
    for (int c = 0; c < HD / 16; ++c) {
        const s16x4 lo = vtr(base + c * 32), hi = vtr(base + 16 * PITCH + c * 32);
        const bf16x8 vf = __builtin_shufflevector(lo, hi, 0, 1, 2, 3, 4, 5, 6, 7);
#pragma unroll
        for (int qb = 0; qb < QB; ++qb) o[c][qb] = MFMA16(vf, pf[qb], o[c][qb]);
    }
}
__device__ __forceinline__ bf16x8 pack8(const f32x4& a, const f32x4& b) { u32x4 w; w.x = pkbf(a.x, a.y); w.y = pkbf(a.z, a.w); w.z = pkbf(b.x, b.y); w.w = pkbf(b.z, b.w); return __builtin_bit_cast(bf16x8, w); }

template <int HD, int QB> __device__ __forceinline__ void softmax_step(f32x4 (&s)[2][QB], const unsigned (&vmask)[QB], float (&m)[QB], float (&l)[QB], f32x4 (&o)[HD / 16][QB], bf16x8 (&pf)[QB]) {
#pragma unroll
    for (int qb = 0; qb < QB; ++qb) {
        float mx = -1e30f;
#pragma unroll
        for (int u = 0; u < 2; ++u)
#pragma unroll
            for (int i = 0; i < 4; ++i) { const bool ok = (vmask[qb] >> (4 * u + i)) & 1u; s[u][qb][i] = ok ? s[u][qb][i] : -1e30f; mx = fmaxf(mx, s[u][qb][i]); }
        mx = fmaxf(mx, __shfl_xor(mx, 16)); mx = fmaxf(mx, __shfl_xor(mx, 32));
        if (!__all(mx - m[qb] <= 8.0f)) {
            const float mn = fmaxf(m[qb], mx), alpha = fexp(m[qb] - mn);
            l[qb] *= alpha; m[qb] = mn;
#pragma unroll
            for (int c = 0; c < HD / 16; ++c) o[c][qb] *= alpha;
        }
        const float ml = m[qb] * 1.4426950408889634f;
        float ps = 0.f;
#pragma unroll
        for (int u = 0; u < 2; ++u)
#pragma unroll
            for (int i = 0; i < 4; ++i) { const bool ok = (vmask[qb] >> (4 * u + i)) & 1u; const float p = ok ? __builtin_amdgcn_exp2f(__builtin_fmaf(s[u][qb][i], 1.4426950408889634f, -ml)) : 0.f; s[u][qb][i] = p; ps += p; }
        l[qb] += ps;
        pf[qb] = pack8(s[0][qb], s[1][qb]);
    }
}
__device__ __forceinline__ void stick_step(f32x4 (&s)[2][1], unsigned vmask, float& R, bf16x8& pf, int fq) {
    float sp[2][4], suf[2][4], tot[2], later[2];
#pragma unroll
    for (int u = 0; u < 2; ++u) {
#pragma unroll
        for (int i = 0; i < 4; ++i) { const bool ok = (vmask >> (4 * u + i)) & 1u; const float z = s[u][0][i];
            sp[u][i] = ok ? (fmaxf(z, 0.f) + flog(1.0f + fexp(-fabsf(z)))) : 0.f; }
        suf[u][3] = sp[u][3]; suf[u][2] = sp[u][2] + suf[u][3]; suf[u][1] = sp[u][1] + suf[u][2]; suf[u][0] = sp[u][0] + suf[u][1];
        const float T = suf[u][0], t1 = __shfl_xor(T, 16), t2 = __shfl_xor(T, 32), t3 = __shfl_xor(T, 48);
        later[u] = ((fq ^ 1) > fq ? t1 : 0.f) + ((fq ^ 2) > fq ? t2 : 0.f) + ((fq ^ 3) > fq ? t3 : 0.f);
        tot[u] = (T + t1) + (t2 + t3);
    }
    f32x4 w[2];
#pragma unroll
    for (int i = 0; i < 4; ++i) {
        const bool ok1 = (vmask >> (4 + i)) & 1u, ok0 = (vmask >> i) & 1u;
        w[1][i] = ok1 ? fexp(s[1][0][i] - (R + later[1] + suf[1][i])) : 0.f;
        w[0][i] = ok0 ? fexp(s[0][0][i] - (R + tot[1] + later[0] + suf[0][i])) : 0.f;
    }
    R += tot[0] + tot[1];
    pf = pack8(w[0], w[1]);
}
template <int HD, int QB> __device__ __forceinline__ void store_o(const f32x4 (&o)[HD / 16][QB], const float (&inv)[QB], bf16* ao  , int nq, int fr, int fq) {
    asm volatile("" : "+v"(fr), "+v"(fq));
#pragma unroll
    for (int qb = 0; qb < QB; ++qb)
#pragma unroll
        for (int c = 0; c < HD / 16; c += 2) {
            const f32x4 xa = o[c][qb] * inv[qb], xb = o[c + 1][qb] * inv[qb];
            unsigned a0 = pkbf(xa.x, xa.y), a1 = pkbf(xa.z, xa.w), b0 = pkbf(xb.x, xb.y), b1 = pkbf(xb.z, xb.w);
            { auto r = __builtin_amdgcn_permlane16_swap(a0, b0, false, false); a0 = r[0]; b0 = r[1]; }
            { auto r = __builtin_amdgcn_permlane16_swap(a1, b1, false, false); a1 = r[0]; b1 = r[1]; }
            u32x4 w; w.x = a0; w.y = a1; w.z = b0; w.w = b1;
            if (16 * qb + fr < nq) *(u32x4*)(ao + (size_t)(16 * qb + fr) * AOW + 16 * (c + (fq & 1)) + 8 * (fq >> 1)) = w; }
}

template <int QB> __device__ __forceinline__ void bias_and_mask(f32x4 (&s)[2][QB], unsigned (&vmask)[QB], const float* relb, int qpos0, int key0, int nvalid, int kpos, int fr, int fq) {
#pragma unroll
    for (int qb = 0; qb < QB; ++qb) { unsigned vm = 0u;
#pragma unroll
        for (int u = 0; u < 2; ++u)
#pragma unroll
            for (int i = 0; i < 4; ++i) { const int kk = key0 + 16 * u + 4 * fq + i; if (kk < nvalid) vm |= 1u << (4 * u + i);
                if (relb) { int rel = (qpos0 + 16 * qb + fr) - (kpos + kk); rel = rel < -128 ? -128 : (rel > 128 ? 128 : rel); s[u][qb][i] += relb[rel + 128]; } }
        vmask[qb] = vm; }
}
template <int QB, bool SEG1, int NSPLIT>
__device__ __forceinline__ void softmax_item(const bf16* q, int qpos0, bf16* ao,
                                             const char* k1, const char* v1, size_t pitch1, int k1lo, int k1hi, int n1, int kpos1,
                                             const char* k2, const char* v2, size_t pitch2, int k2lo, int k2hi, int n2, int kpos2,
                                             const float* relb, LAS char* lds0, int wave, int lane) {
    constexpr int HD = 128;
    const int fr = lane & 15, fq = lane >> 4;
    LAS char* vt = lds0 + wave * VT_STRIDE;
    bf16x8 qf[QB][HD / 32]; load_q<HD, QB>(qf, q, fr, fq);
    f32x4 o[HD / 16][QB]; float m[QB], l[QB];
#pragma unroll
    for (int qb = 0; qb < QB; ++qb) { m[qb] = -1e30f; l[qb] = 0.f;
#pragma unroll
        for (int c = 0; c < HD / 16; ++c) o[c][qb] = (f32x4){0.f, 0.f, 0.f, 0.f}; }
    f32x4 s[2][QB]; bf16x8 pf[QB]; unsigned vmask[QB];
    if constexpr (SEG1) {
        for (int key0 = k1lo; key0 < k1hi; key0 += 32) {
            qk_tile<HD, QB, true>(s, qf, k1, pitch1, key0, n1 - 1, fr, fq);
            stage_v<HD, true>(vt, v1, pitch1, key0, n1 - 1, lane);
            bias_and_mask<QB>(s, vmask, relb, qpos0, key0, n1, kpos1, fr, fq);
            softmax_step<HD, QB>(s, vmask, m, l, o, pf);
            pv_tile<HD, QB>(o, pf, vt, lane);
        }
    }
    for (int key0 = k2lo; key0 < k2hi; key0 += 32) {
        qk_tile<HD, QB, false>(s, qf, k2, pitch2, key0, n2 - 1, fr, fq);
        stage_v<HD, false>(vt, v2, pitch2, key0, n2 - 1, lane);
        bias_and_mask<QB>(s, vmask, relb, qpos0, key0, n2, kpos2, fr, fq);
        softmax_step<HD, QB>(s, vmask, m, l, o, pf);
        pv_tile<HD, QB>(o, pf, vt, lane);
    }
#pragma unroll
    for (int qb = 0; qb < QB; ++qb) { float t = l[qb]; t += __shfl_xor(t, 16); t += __shfl_xor(t, 32); l[qb] = t; }
    if constexpr (NSPLIT > 1) {
        static_assert(QB == 1, "split items are 16-query items");
        LAS f32x4* po = (LAS f32x4*)(vt + 9216);
#pragma unroll
        for (int c = 0; c < HD / 16; ++c) po[c * 64 + lane] = o[c][0];
        { LAS float* ml = (LAS float*)(lds0 + 139264 + 512 * wave); ml[lane] = m[0]; ml[64 + lane] = l[0]; }
        __syncthreads();
        if ((wave % NSPLIT) == 0) {
            float mk[NSPLIT], lk[NSPLIT], M = -1e30f;
#pragma unroll
            for (int k = 0; k < NSPLIT; ++k) { const LAS float* ml = (const LAS float*)(lds0 + 139264 + 512 * (wave + k)); mk[k] = ml[lane]; lk[k] = ml[64 + lane]; M = fmaxf(M, mk[k]); }
            float L = 0.f;
#pragma unroll
            for (int k = 0; k < NSPLIT; ++k) { mk[k] = fexp(mk[k] - M); L += lk[k] * mk[k]; }
#pragma unroll
            for (int c = 0; c < HD / 16; ++c) { f32x4 a = {0.f, 0.f, 0.f, 0.f};
#pragma unroll
                for (int k = 0; k < NSPLIT; ++k) a += ((const LAS f32x4*)(lds0 + (wave + k) * VT_STRIDE + 9216))[c * 64 + lane] * mk[k];
                o[c][0] = a; }
            const float inv[1] = {1.0f / L};
            store_o<HD, 1>(o, inv, ao, 16, fr, fq);
        }
        __syncthreads();
    } else {
        float inv[QB];
#pragma unroll
        for (int qb = 0; qb < QB; ++qb) inv[qb] = 1.0f / l[qb];
        store_o<HD, QB>(o, inv, ao, 16 * QB, fr, fq);
    }
}

constexpr int BPITCH = 272, BK_BYTES = 64 * BPITCH;
template <int QB, int HD = 128, int PITCH = BPITCH> __device__ __forceinline__ void qk_tile_lds(f32x4 (&s)[2][QB], const bf16x8 (&qf)[QB][HD / 32], const LAS char* kt, int fr, int fq) {
#pragma unroll
    for (int u = 0; u < 2; ++u) {
        const LAS char* rp = kt + (16 * u + fr) * PITCH + 16 * fq;
        bf16x8 kf[HD / 32];
#pragma unroll
        for (int ks = 0; ks < HD / 32; ++ks) kf[ks] = *(const LAS bf16x8*)(rp + 64 * ks);
#pragma unroll
        for (int qb = 0; qb < QB; ++qb) { f32x4 a = {0.f, 0.f, 0.f, 0.f};
#pragma unroll
            for (int ks = 0; ks < HD / 32; ++ks) a = MFMA16(kf[ks], qf[qb][ks], a);
            s[u][qb] = a; }
    }
}
template <bool BAND>
__device__ __forceinline__ void softmax_block(const bf16* q  , bf16* ao, const char* kbase, const char* vbase, size_t pitchB,
                                              int kc_lo, int kc_hi  , int c0  , const float* relb, LAS char* lds, int tid) {
    constexpr int HD = 128, QB = 2;
    const int lane = tid & 63, wave = __builtin_amdgcn_readfirstlane(tid >> 6), fr = lane & 15, fq = lane >> 4;
    const int srow = tid >> 4, sch = tid & 15;
    bf16x8 pk[2], pw[2];
#define SB_ISSUE(kc) do { _Pragma("unroll") for (int i_ = 0; i_ < 2; ++i_) { const size_t go_ = (size_t)((kc) * 64 + srow + 32 * i_) * pitchB + sch * 16; \
        pk[i_] = *(const bf16x8*)(kbase + go_); pw[i_] = *(const bf16x8*)(vbase + go_); } } while (0)
#define SB_WRITE(buf) do { _Pragma("unroll") for (int i_ = 0; i_ < 2; ++i_) { const int lo_ = (srow + 32 * i_) * BPITCH + sch * 16; \
        *(LAS bf16x8*)(lds + (buf) * BK_BYTES + lo_) = pk[i_]; *(LAS bf16x8*)(lds + (2 + (buf)) * BK_BYTES + lo_) = pw[i_]; } } while (0)
    SB_ISSUE(kc_lo);
    LAS float* bt = (LAS float*)(lds + 4 * BK_BYTES);
    if (BAND) for (int i = tid; i < 257; i += 512) bt[i] = relb[i];
    bf16x8 qf[QB][4]; load_q<HD, QB>(qf, q + (size_t)(32 * wave) * QKVW, fr, fq);
    f32x4 o[HD / 16][QB]; float m[QB], l[QB];
#pragma unroll
    for (int qb = 0; qb < QB; ++qb) { m[qb] = -1e30f; l[qb] = 0.f;
#pragma unroll
        for (int c = 0; c < HD / 16; ++c) o[c][qb] = (f32x4){0.f, 0.f, 0.f, 0.f}; }
    SB_WRITE(0);
    __syncthreads();
    const int cw = c0 + (wave >> 1), qp0 = c0 * 64 + 32 * wave;
    const unsigned vall[QB] = {0xffu, 0xffu};
    for (int kc = kc_lo; kc < kc_hi; ++kc) {
        const int buf = (kc - kc_lo) & 1;
        if (kc + 1 < kc_hi) SB_ISSUE(kc + 1);
        if (!BAND || (kc >= cw - 8 && kc <= cw)) {
#pragma unroll
            for (int sub = 0; sub < 2; ++sub) {
                f32x4 s[2][QB]; bf16x8 pf[QB];
                qk_tile_lds<QB>(s, qf, lds + buf * BK_BYTES + sub * 32 * BPITCH, fr, fq);
                if (BAND) {
                    const int kp0 = kc * 64 + sub * 32;
                    if (qp0 - (kp0 + 31) >= 128) { const float bfar = bt[256];
#pragma unroll
                        for (int qb = 0; qb < QB; ++qb)
#pragma unroll
                            for (int u = 0; u < 2; ++u) s[u][qb] += bfar;
                    } else {
#pragma unroll
                        for (int qb = 0; qb < QB; ++qb)
#pragma unroll
                            for (int u = 0; u < 2; ++u)
#pragma unroll
                                for (int i = 0; i < 4; ++i) { int rel = (qp0 + 16 * qb + fr) - (kp0 + 16 * u + 4 * fq + i); rel = rel < -128 ? -128 : (rel > 128 ? 128 : rel); s[u][qb][i] += bt[rel + 128]; }
                    }
                }
                softmax_step<HD, QB>(s, vall, m, l, o, pf);
                pv_tile<HD, QB, BPITCH>(o, pf, lds + (2 + buf) * BK_BYTES + sub * 32 * BPITCH, lane);
            }
        }
        if (kc + 1 < kc_hi) SB_WRITE(buf ^ 1);
        __syncthreads();
    }
#undef SB_ISSUE
#undef SB_WRITE
    float inv[QB];
#pragma unroll
    for (int qb = 0; qb < QB; ++qb) { float t = l[qb]; t += __shfl_xor(t, 16); t += __shfl_xor(t, 32); inv[qb] = 1.0f / t; }
    store_o<HD, QB>(o, inv, ao + (size_t)(32 * wave) * AOW, 32, fr, fq);
}

template <bool SEG1>
__device__ __forceinline__ void stick_item(const bf16* q, int q0, bf16* ao,
                                           const char* k1, const char* v1, size_t pitch1, int n1,
                                           const char* k2, const char* v2, size_t pitch2, int n2,
                                           LAS char* vt, int lane) {
    constexpr int HD = 256;
    const int fr = lane & 15, fq = lane >> 4;
    bf16x8 qf[1][HD / 32]; load_q<HD, 1>(qf, q, fr, fq);
    f32x4 o[HD / 16][1];
#pragma unroll
    for (int c = 0; c < HD / 16; ++c) o[c][0] = (f32x4){0.f, 0.f, 0.f, 0.f};
    float R = 0.f; f32x4 s[2][1]; bf16x8 pf[1]; bool done = false;
    for (int key0 = (q0 >> 5) << 5; key0 >= 0; key0 -= 32) {
        qk_tile<HD, 1, false>(s, qf, k2, pitch2, key0, n2 - 1, fr, fq);
        stage_v<HD, false>(vt, v2, pitch2, key0, n2 - 1, lane);
        unsigned vm = 0u;
#pragma unroll
        for (int u = 0; u < 2; ++u)
#pragma unroll
            for (int i = 0; i < 4; ++i) { const int kk = key0 + 16 * u + 4 * fq + i; if (kk < n2 && kk < q0 + fr) vm |= 1u << (4 * u + i); }
        stick_step(s, vm, R, pf[0], fq);
        pv_tile<HD, 1>(o, pf, vt, lane);
#if SB_EARLY
        if (__all(R > 110.0f)) { done = true; break; }
#endif
    }
    if constexpr (SEG1) {
        if (!done) for (int key0 = n1 - 32; key0 >= 0; key0 -= 32) {
            { GAS const char* a_ = (GAS const char*)k1; GAS const char* b_ = (GAS const char*)v1; asm volatile("" : "+s"(a_), "+s"(b_)); k1 = (const char*)a_; v1 = (const char*)b_; }
            qk_tile<HD, 1, true>(s, qf, k1, pitch1, key0, n1 - 1, fr, fq);
            stage_v<HD, true>(vt, v1, pitch1, key0, n1 - 1, lane);
            stick_step(s, 0xffu, R, pf[0], fq);
            pv_tile<HD, 1>(o, pf, vt, lane);
#if SB_EARLY
            if (__all(R > 110.0f)) break;
#endif
        }
    }
    const float inv[1] = {1.0f};
    store_o<HD, 1>(o, inv, ao, 16, fr, fq);
}

constexpr int SPITCH = 528, SK_BYTES = 32 * SPITCH;
__device__ __forceinline__ void stick_block(const bf16* q  , bf16* ao, const char* kbase, const char* vbase, size_t pitchB, int Q0, LAS char* lds, int tid) {
    constexpr int HD = 256;
    const int lane = tid & 63, wave = __builtin_amdgcn_readfirstlane(tid >> 6), fr = lane & 15, fq = lane >> 4;
    const int srow = tid >> 5, sch = tid & 31;
    bf16x8 pk[2], pw[2];
#define ST_ISSUE(kt) do { _Pragma("unroll") for (int i_ = 0; i_ < 2; ++i_) { const size_t go_ = (size_t)((kt) * 32 + srow + 16 * i_) * pitchB + sch * 16; \
        pk[i_] = *(const bf16x8*)(kbase + go_); pw[i_] = *(const bf16x8*)(vbase + go_); } } while (0)
#define ST_WRITE(buf) do { _Pragma("unroll") for (int i_ = 0; i_ < 2; ++i_) { const int lo_ = (srow + 16 * i_) * SPITCH + sch * 16; \
        *(LAS bf16x8*)(lds + (buf) * SK_BYTES + lo_) = pk[i_]; *(LAS bf16x8*)(lds + (2 + (buf)) * SK_BYTES + lo_) = pw[i_]; } } while (0)
    const int kt_hi = (Q0 >> 5) + 3, q0w = Q0 + 16 * wave, dt = q0w >> 5;
    ST_ISSUE(kt_hi);
    volatile LAS int* fl = (volatile LAS int*)(lds + 4 * SK_BYTES);
    bf16x8 qf[1][HD / 32]; load_q<HD, 1>(qf, q + (size_t)(16 * wave) * QKVW, fr, fq);
    f32x4 o[HD / 16][1];
#pragma unroll
    for (int c = 0; c < HD / 16; ++c) o[c][0] = (f32x4){0.f, 0.f, 0.f, 0.f};
    float R = 0.f; int mydone = 0;
    ST_WRITE(0);
    __syncthreads();
    for (int kt = kt_hi; kt >= 0; --kt) {
        const int buf = (kt_hi - kt) & 1;
        if (kt > 0) ST_ISSUE(kt - 1);
        if (!mydone && kt <= dt) {
            f32x4 s[2][1]; bf16x8 pf[1];
            qk_tile_lds<1, HD, SPITCH>(s, qf, lds + buf * SK_BYTES, fr, fq);
            unsigned vm = 0xffu;
            if (kt == dt) { vm = 0u;
#pragma unroll
                for (int u = 0; u < 2; ++u)
#pragma unroll
                    for (int i = 0; i < 4; ++i) if (kt * 32 + 16 * u + 4 * fq + i < q0w + fr) vm |= 1u << (4 * u + i); }
            stick_step(s, vm, R, pf[0], fq);
            pv_tile<HD, 1, SPITCH>(o, pf, lds + (2 + buf) * SK_BYTES, lane);
#if SB_EARLY
            if (__all(R > 110.0f)) mydone = 1;
#endif
        }
        if (kt > 0) ST_WRITE(buf ^ 1);
        if (lane == 0) fl[buf * 8 + wave] = mydone;
        __syncthreads();
        int alld = 1;
#pragma unroll
        for (int w = 0; w < 8; ++w) alld &= fl[buf * 8 + w];
        if (alld) break;
    }
#undef ST_ISSUE
#undef ST_WRITE
    const float inv[1] = {1.0f};
    store_o<HD, 1>(o, inv, ao + (size_t)(16 * wave) * AOW, 16, fr, fq);
    __syncthreads();
}

__device__ __forceinline__ void stick_sample_split(const bf16* q, bf16* ao, const char* k1, const char* v1, size_t pitch1, int n1,
                                                   const char* k2, const char* v2, size_t pitch2, int n2, LAS char* lds0, int wave, int lane) {
    constexpr int HD = 256;
    const int fr = lane & 15, fq = lane >> 4;
    LAS char* vt = lds0 + wave * VT_STRIDE;
    LAS float* tw = (LAS float*)(lds0 + 139264);
    {
        bf16x8 qf[1][HD / 32]; load_q<HD, 1>(qf, q, fr, fq);
        f32x4 o[HD / 16][1];
#pragma unroll
        for (int c = 0; c < HD / 16; ++c) o[c][0] = (f32x4){0.f, 0.f, 0.f, 0.f};
        float R = 0.f; f32x4 s[2][1]; bf16x8 pf[1]; unsigned vm = 0xffu;
        if (wave == 0) {
            qk_tile<HD, 1, false>(s, qf, k2, pitch2, 0, n2 - 1, fr, fq);
            stage_v<HD, false>(vt, v2, pitch2, 0, n2 - 1, lane);
            vm = 0u;
#pragma unroll
            for (int u = 0; u < 2; ++u)
#pragma unroll
                for (int i = 0; i < 4; ++i) { const int kk = 16 * u + 4 * fq + i; if (kk < n2 && kk < fr) vm |= 1u << (4 * u + i); }
        } else {
            const int key0 = n1 - 32 * wave;
            qk_tile<HD, 1, true>(s, qf, k1, pitch1, key0, n1 - 1, fr, fq);
            stage_v<HD, true>(vt, v1, pitch1, key0, n1 - 1, lane);
        }
        stick_step(s, vm, R, pf[0], fq);
        pv_tile<HD, 1>(o, pf, vt, lane);
        LDS_WAIT();
        LAS f32x4* po = (LAS f32x4*)vt;
#pragma unroll
        for (int c = 0; c < HD / 16; ++c) po[c * 64 + lane] = o[c][0];
        tw[wave * 64 + lane] = R;
    }
    __syncthreads();
    float Rl[8], Rtot = 0.f;
#pragma unroll
    for (int w = 0; w < 8; ++w) { Rl[w] = fexp(-Rtot); Rtot += tw[w * 64 + lane]; }
    const bool fast = __all(Rtot > 110.0f);
    if (fast) {
        int fr2 = fr, fq2 = fq; asm volatile("" : "+v"(fr2), "+v"(fq2));
#pragma unroll
        for (int cc = 0; cc < 2; ++cc) { const int c = 2 * wave + cc; f32x4 a = {0.f, 0.f, 0.f, 0.f};
#pragma unroll
            for (int w = 0; w < 8; ++w) a += ((const LAS f32x4*)(lds0 + w * VT_STRIDE))[c * 64 + lane] * Rl[w];
            u32x2 wv; wv.x = pkbf(a.x, a.y); wv.y = pkbf(a.z, a.w);
            *(u32x2*)(ao + (size_t)fr2 * AOW + 16 * c + 4 * fq2) = wv; }
    }
    __syncthreads();
    if (!fast && wave == 0) stick_item<true>(q, 0, ao, k1, v1, pitch1, n1, k2, v2, pitch2, n2, vt, lane);
    __syncthreads();
}
}

struct P0Item { const float* W; bf16* WT; const float* gain; float scale; int K, N, ffn_up, item; };
__device__ __forceinline__ void p0_load(const P0Item& d, f32x4 (&v)[8], int lane) {
    const int nblk = d.N / 32, kb = d.item / nblk, nb = d.item % nblk, k0 = 64 * kb, n0 = 32 * nb;
    const float* p = d.W + (size_t)(k0 + (lane >> 3)) * d.N + n0 + 4 * (lane & 7);
#pragma unroll
    for (int i = 0; i < 8; ++i) v[i] = *(const f32x4*)(p + (size_t)(8 * i) * d.N);
}
__device__ __forceinline__ void p0_store(const P0Item& d, const f32x4 (&v)[8], LAS float* scr, int lane) {
    const int nblk = d.N / 32, kb = d.item / nblk, nb = d.item % nblk, k0 = 64 * kb, n0 = 32 * nb;
    int r0 = n0;
    if (d.ffn_up) { const int j0 = n0 < DFF ? n0 : n0 - DFF; r0 = 256 * (j0 >> 7) + (n0 < DFF ? 0 : 128) + (j0 & 127); }
#pragma unroll
    for (int i = 0; i < 8; ++i) { const int kk = 8 * i + (lane >> 3); const float g = d.gain ? d.gain[k0 + kk] * d.scale : d.scale;
        *(LAS f32x4*)(scr + kk * 36 + 4 * (lane & 7)) = v[i] * g; }
    LDS_WAIT(); asm volatile("" ::: "memory");
    const int c = lane & 7;
#pragma unroll
    for (int j = 0; j < 4; ++j) { const int n = (lane >> 3) + 8 * j; const LAS float* s = scr + (8 * c) * 36 + n;
        u32x4 o; o.x = pkbf(s[0 * 36], s[1 * 36]); o.y = pkbf(s[2 * 36], s[3 * 36]); o.z = pkbf(s[4 * 36], s[5 * 36]); o.w = pkbf(s[6 * 36], s[7 * 36]);
        *(u32x4*)(d.WT + (size_t)(r0 + n) * d.K + k0 + 8 * c) = o; }
    LDS_WAIT(); asm volatile("" ::: "memory");
}
__device__ __forceinline__ float wave_sum(float v) {
#pragma unroll
    for (int o = 1; o < 64; o <<= 1) v += __shfl_xor(v, o);
    return v;
}
__device__ __forceinline__ void p0_row(const float* xrow, bf16* orow, float* ssq_row, int norm, int lane) {
    const f32x4* xr = (const f32x4*)xrow + lane;
    f32x4 v[8]; float s = 0.f;
#pragma unroll
    for (int j = 0; j < 8; ++j) { v[j] = xr[64 * j]; s += dot4(v[j]); }
    s = wave_sum(s);
    const float sc = norm ? __builtin_amdgcn_rsqf(s * (1.0f / DM) + EPS) : 1.0f;
    u32x2* o8 = (u32x2*)orow + lane;
#pragma unroll
    for (int j = 0; j < 8; ++j) { u32x2 w; w.x = pkbf(v[j].x * sc, v[j].y * sc); w.y = pkbf(v[j].z * sc, v[j].w * sc); o8[64 * j] = w; }
    if (ssq_row && lane < 8) ssq_row[lane] = lane == 0 ? s : 0.f;
}

template <class Sched> __device__ __forceinline__ void run_up(LAS unsigned char* lds, const bf16* A, const bf16* Bt, const Sched& S, bf16* HB, const float* ssq, int& tidv) {
    pg8::Gemm g{A, Bt, MR, 2 * DFF, DM}; EpiSwiGLU E{HB, ssq, (LAS float*)(lds + TAB2_OFF)}; pg8::gemm_phase<EpiSwiGLU, Sched, true, true>(lds, g, S, E, tidv); }
template <bool APAIR, class Sched> __device__ __forceinline__ void run_resid(LAS unsigned char* lds, const bf16* A, const bf16* Bt, int K, const Sched& S, bf16* XB, float* outf, float* ssq_out, LAS float* tab, int& tidv) {
    pg8::Gemm g{A, Bt, MR, DM, K}; EpiResid E{XB, outf, ssq_out, tab}; pg8::gemm_phase<EpiResid, Sched, true, true, APAIR>(lds, g, S, E, tidv); }
template <class Sched> __device__ __forceinline__ void run_qkv(LAS unsigned char* lds, const bf16* A, const bf16* Bt, const Sched& S, const EpiQKV& E, int& tidv) {
    pg8::Gemm g{A, Bt, MRX, INW, DM}; pg8::gemm_phase<EpiQKV, Sched, true, true>(lds, g, S, E, tidv); }
struct Params { const float* in[25]; float* out; unsigned char* ws; int ph_lo, ph_hi, bar_idx, pad; };
__global__ void __launch_bounds__(512, 2) fwd(Params P) {
    extern __shared__ __attribute__((aligned(16))) unsigned char lds_raw[];
    LAS unsigned char* lds = (LAS unsigned char*)lds_raw;
    int tidv = threadIdx.x;
    const int tid = tidv, lane = tid & 63, wave = __builtin_amdgcn_readfirstlane(tid >> 6);
    const int G = gridDim.x, gw = blockIdx.x * 8 + wave, NGW = G * 8;
    unsigned char* ws = P.ws; float* out = P.out;
    volatile LAS unsigned* MISC = (volatile LAS unsigned*)(lds + MISC_OFF);
    if (tid < 32) MISC[tid] = 0u;
    __syncthreads();
    unsigned* ctl = (unsigned*)(ws + WS_CTL);
    XcdBarrier bar; bar.bar = ctl + 4096; bar.x = 0; bar.st = nullptr;
    if (!MK_MULTI) bar = xcd_barrier_post(ctl + 4096, MISC + 8);
    const int lo = P.ph_lo, hi = P.ph_hi;
#define IN(k) (lo <= (k) && (k) < hi)
#define SEAM(k) do { if (IN(k) && IN((k) + 1)) { XcdBarrier b_ = bar; { GAS unsigned* t_ = (GAS unsigned*)bar.bar; asm volatile("" : "+s"(t_), "+s"(b_.x)); b_.bar = (unsigned*)t_; } xcd_barrier(b_); } } while (0)
#define STAGGER() do { if (STAGGER_US > 0) { const unsigned long long t0_ = __builtin_amdgcn_s_memrealtime(), d_ = (unsigned long long)(blockIdx.x % 256u) * (unsigned)(STAGGER_US * 100) / 256u; \
        while (__builtin_amdgcn_s_memrealtime() - t0_ < d_) __builtin_amdgcn_s_sleep(4); } } while (0)
    bf16* XB = (bf16*)(ws + WS_XB); bf16* HB = (bf16*)(ws + WS_H); bf16* QKV = (bf16*)(ws + WS_QKV); bf16* AO = (bf16*)(ws + WS_AO); bf16* MKV = (bf16*)(ws + WS_MKV);
    float* SSQ = (float*)(ws + WS_SSQ);
    LAS float* TAB1 = (LAS float*)(lds + TAB1_OFF); LAS float* TAB2 = (LAS float*)(lds + TAB2_OFF);

    for (int rep = 0; rep < 1 + DUP_P0; ++rep) if (IN(0)) {
        LAS float* scr = (LAS float*)(lds + wave * 16384);
        constexpr int I_U = (DM / 64) * (2 * DFF / 32), I_D = (DFF / 64) * (DM / 32), I_IN = (DM / 64) * (QKVW / 32), I_MK = (DM / 64) * (1024 / 32), I_O = (AOW / 64) * (DM / 32);
        constexpr int I_LAYER = 2 * I_U + 2 * I_D + I_IN + I_MK + I_O, I_W = NLAYER * I_LAYER, I_ALL = I_W + MRX;
        auto decode = [&](int it) {
            P0Item d; const int l = it / I_LAYER; int r = it % I_LAYER;
            char* LW = (char*)(ws + WS_W + (size_t)l * LW_SIZE);
            d.gain = nullptr; d.scale = 1.0f; d.ffn_up = 0;
            if (r < I_U) { d.W = P.in[10] + (size_t)l * DM * 2 * DFF; d.K = DM; d.N = 2 * DFF; d.WT = (bf16*)(LW + LW_1U); d.gain = P.in[9] + l * DM; d.ffn_up = 1; d.item = r; return d; } r -= I_U;
            if (r < I_D) { d.W = P.in[11] + (size_t)l * DFF * DM; d.K = DFF; d.N = DM; d.WT = (bf16*)(LW + LW_1D); d.scale = 0.5f; d.item = r; return d; } r -= I_D;
            if (r < I_IN) { d.W = P.in[13] + (size_t)l * DM * QKVW; d.K = DM; d.N = QKVW; d.WT = (bf16*)(LW + LW_IN); d.gain = P.in[12] + l * DM; d.item = r; return d; } r -= I_IN;
            if (r < I_MK) { d.W = P.in[19] + (size_t)l * DM * 1024; d.K = DM; d.N = 1024; d.WT = (bf16*)(LW + LW_IN) + (size_t)QKVW * DM; d.gain = P.in[18] + l * DM; d.item = r; return d; } r -= I_MK;
            if (r < I_O) { d.W = P.in[14] + (size_t)l * AOW * DM; d.K = AOW; d.N = DM; d.WT = (bf16*)(LW + LW_O); d.item = r; return d; } r -= I_O;
            if (r < I_U) { d.W = P.in[23] + (size_t)l * DM * 2 * DFF; d.K = DM; d.N = 2 * DFF; d.WT = (bf16*)(LW + LW_2U); d.gain = P.in[22] + l * DM; d.ffn_up = 1; d.item = r; return d; } r -= I_U;
            d.W = P.in[24] + (size_t)l * DFF * DM; d.K = DFF; d.N = DM; d.WT = (bf16*)(LW + LW_2D); d.scale = 0.5f; d.item = r; return d;
        };
        {
            int it = gw; f32x4 va[8], vb[8]; P0Item da, db;
            if (it < I_W) { da = decode(it); p0_load(da, va, lane); }
            while (it < I_W) {
                const int itn = it + NGW;
                if (itn < I_W) { db = decode(itn); p0_load(db, vb, lane); }
                p0_store(da, va, scr, lane);
                it = itn;
                if (it >= I_W) break;
                const int itn2 = it + NGW;
                if (itn2 < I_W) { da = decode(itn2); p0_load(da, va, lane); }
                p0_store(db, vb, scr, lane);
                it = itn2;
            }
        }
        for (int m = gw; m < MRX; m += NGW) {
            const float* src = m < NP ? P.in[0] + (size_t)m * DM : m < MR ? P.in[1] + (size_t)(m - NP) * DM : P.in[2] + (size_t)(m - MR) * DM;
            p0_row(src, XB + (size_t)m * DM, m < MR ? SSQ + (size_t)m * 8 : nullptr, m >= MR, lane);
        }
    }
    if (IN(0) && blockIdx.x == 0) {
        float* gd = (float*)(ws + WS_DBG);
        for (int i = tid; i < NLAYER * 512; i += 512) { const int l = i >> 9, k = (i >> 7) & 3, d = i & 127;
            gd[i] = k == 0 ? P.in[15][(l >> 1) * 128 + d] : k == 1 ? P.in[16][(l >> 1) * 128 + d] : k == 2 ? P.in[20][l * 128 + d] : P.in[21][l * 128 + d]; }
    }
    SEAM(0);

    int dbase = 0;
    for (int l = 0; l < NLAYER; ++l) {
        const int pb = 1 + 7 * l, e = l & 1, j = l >> 1;
        if (hi <= pb || lo >= pb + 7) continue;
        GAS unsigned char* wsg_ = (GAS unsigned char*)P.ws; GAS float* outg_ = (GAS float*)P.out; asm volatile("" : "+s"(wsg_), "+s"(outg_));
        unsigned char* ws = (unsigned char*)wsg_; float* out = (float*)outg_;
        bf16* XB = (bf16*)(ws + WS_XB); bf16* HB = (bf16*)(ws + WS_H); bf16* QKV = (bf16*)(ws + WS_QKV); bf16* AO = (bf16*)(ws + WS_AO); bf16* MKV = (bf16*)(ws + WS_MKV);
        float* SSQ = (float*)(ws + WS_SSQ); unsigned* ctl = (unsigned*)(ws + WS_CTL);
        const char* LW = (const char*)(ws + WS_W + (size_t)l * LW_SIZE);
        float* ssqA = SSQ + (size_t)e * SSQ_BUF; float* ssqB = SSQ + (size_t)(1 - e) * SSQ_BUF;
#define PCW(s_) (ctl + PC_WORD0 + (size_t)((l * 5 + (s_)) * 132) * PC_STRIDE)
#define TMOW (ctl + 4096 + XB_TMO)
#define W0 (__builtin_amdgcn_readfirstlane(tidv >> 6) == 0)
        if (IN(pb + 0)) {
            int bx = blockIdx.x; asm volatile("" : "+s"(bx));
            Gated<XcdDeal> S; S.init(24, 48, bx, dbase); S.rdy = -1; S.g = Gate{l > 0 ? PCW(0) : nullptr, 64u, PCW(1), TMOW, W0};
            run_up(lds, XB, (const bf16*)(LW + LW_1U), S, HB, ssqA, tidv);
        }
        if (IN(pb + 1)) {
            Gated<XcdDeal> S; int bx = blockIdx.x; asm volatile("" : "+s"(bx)); S.init(8, 16, bx, dbase); S.rdy = -1; S.g = Gate{PCW(1), 192u, PCW(2), TMOW, W0};
            run_resid<true>(lds, HB, (const bf16*)(LW + LW_1D), DFF, S, XB, nullptr, ssqB, TAB1, tidv);
        }
        if (IN(pb + 2)) {
            Gated<DynDeal> S; int bx = blockIdx.x; asm volatile("" : "+s"(bx)); S.nN = 14; S.T = 36; S.x = bx & 7; S.w0 = W0; S.ctr = ctl + DC_WORD0 + (l * 2 + 0) * 128; S.par = 0; S.rdy = -1; S.g = Gate{PCW(2), 64u, ctl + BC_WORD0 + 64 * l, TMOW, W0, 1};
            EpiQKV E{QKV, MKV + (size_t)l * NMR * 1024, ssqB, (const float*)(ws + WS_DBG) + l * 512, out, l, TAB2, (LAS float*)(lds + TAB3_OFF)};
            run_qkv(lds, XB, (const bf16*)(LW + LW_IN), S, E, tidv);
        }
        if (IN(pb + 3)) {
            asm volatile("" : "+v"(tidv)); __builtin_assume(tidv >= 0 && tidv < 512); const int tid_ = tidv;
            const int tid = tid_, lane = tid_ & 63;
            unsigned* qctr = ctl + 65536 + 64 * 4 * l;
            volatile LAS int* dq = (volatile LAS int*)(lds + MISC_OFF + 64);
            unsigned* bcw = ctl + BC_WORD0 + 64 * l; int rdymask = 0;
#define WAIT_CTR(idx_) do { if (!((rdymask >> (idx_)) & 1)) { if (tid == 0) { const unsigned nd_ = (idx_) < 2 ? 64u * 14u * 8u : (idx_) == 2 ? 2u * 14u * 8u : 64u; const unsigned* p_ = bcw + 16 * (idx_); unsigned sp_ = 0; \
                while (__hip_atomic_load(p_, RLX_AGENT) < nd_) { if ((++sp_ & 255u) == 0u) { if (__hip_atomic_load(TMOW, RLX_AGENT) != 0u) break; if (sp_ > (1u << 18)) { __hip_atomic_store(TMOW, 1u, RLX_AGENT); break; } } __builtin_amdgcn_s_sleep(2); } \
                __builtin_amdgcn_fence(__ATOMIC_ACQUIRE, "agent"); asm volatile("s_waitcnt vmcnt(0)" ::: "memory"); } \
            __syncthreads(); rdymask |= 1 << (idx_); } } while (0)
#define DYN_ITEMS(ctr, N, ...) do { int cur_, par_ = 0; __syncthreads(); if (tid == 0) dq[0] = (int)__hip_atomic_fetch_add((ctr), 1u, __ATOMIC_RELAXED, __HIP_MEMORY_SCOPE_AGENT); \
                __syncthreads(); cur_ = __builtin_amdgcn_readfirstlane(dq[0]); \
                while (cur_ < (N)) { int nx_ = 0; if (tid == 0) nx_ = (int)__hip_atomic_fetch_add((ctr), 1u, __ATOMIC_RELAXED, __HIP_MEMORY_SCOPE_AGENT); \
                    const int it = cur_; __VA_ARGS__; \
                    par_ ^= 1; if (tid == 0) dq[par_] = nx_; __syncthreads(); cur_ = __builtin_amdgcn_readfirstlane(dq[par_]); } } while (0)
            if (!e) {
                const float* relb = P.in[17] + (size_t)j * 8 * 257;
                DYN_ITEMS(qctr + 64, NB * 8 * (SEQ / 256), {
                    const int qb = it % (SEQ / 256), h = (it / (SEQ / 256)) % 8, b = it / (8 * (SEQ / 256)), c0 = qb * 4;
                    WAIT_CTR(b);
                    const bf16* rowb = QKV + (size_t)b * SEQ * QKVW;
                    att::softmax_block<true>(rowb + (size_t)(qb * 256) * QKVW + h * 128, AO + (size_t)(b * SEQ + qb * 256) * AOW + h * 128,
                                             (const char*)(rowb + TOKW + h * 128), (const char*)(rowb + 2 * TOKW + h * 128), (size_t)QKVW * 2,
                                             c0 >= 8 ? c0 - 8 : 0, c0 + 4, c0, relb + h * 257, (LAS char*)lds, tid);
                });
                DYN_ITEMS(qctr, DBAT * 4, {
                    WAIT_CTR(2);
                    const int it2 = it * 2 + (wave >> 2), sp = wave & 3, h = it2 % 8, sb = it2 / 8;
                    const bf16* rowb = QKV + (size_t)(NP + sb * DSEQ) * QKVW;
                    const float* ck = P.in[3] + ((size_t)(j * DBAT + sb) * ACACHE) * TOKW + h * 128; const float* cv = P.in[4] + ((size_t)(j * DBAT + sb) * ACACHE) * TOKW + h * 128;
                    att::softmax_item<1, true, 4>(rowb + h * 128, PAST, AO + (size_t)(NP + sb * DSEQ) * AOW + h * 128,
                                                  (const char*)ck, (const char*)cv, (size_t)TOKW * 4, sp * 128, sp * 128 + 128, ACACHE, PAST - ACACHE,
                                                  (const char*)(rowb + TOKW + h * 128), (const char*)(rowb + 2 * TOKW + h * 128), (size_t)QKVW * 2, 0, sp == 3 ? 32 : 0, DSEQ, PAST,
                                                  relb + h * 257, (LAS char*)lds, wave, lane);
                });
            } else {
                DYN_ITEMS(qctr + 64, NB * 4 * (SEQ / 128), {
                    const int b = it / (4 * (SEQ / 128)), r_ = it % (4 * (SEQ / 128)), qb = (SEQ / 128) - 1 - r_ / 4, h = r_ & 3, Q0 = qb * 128;
                    WAIT_CTR(b);
                    const bf16* rowb = QKV + (size_t)b * SEQ * QKVW;
                    att::stick_block(rowb + (size_t)Q0 * QKVW + h * 256, AO + (size_t)(b * SEQ + Q0) * AOW + h * 256,
                                     (const char*)(rowb + TOKW + h * 256), (const char*)(rowb + 2 * TOKW + h * 256), (size_t)QKVW * 2, Q0, (LAS char*)lds, tid);
                });
#if SB_EARLY
                DYN_ITEMS(qctr, DBAT * 4, {
                    WAIT_CTR(2);
                    const int h = it % 4, sb = it / 4;
                    const bf16* rowb = QKV + (size_t)(NP + sb * DSEQ) * QKVW;
                    const float* ck = P.in[5] + ((size_t)(j * DBAT + sb) * PAST) * TOKW + h * 256; const float* cv = P.in[6] + ((size_t)(j * DBAT + sb) * PAST) * TOKW + h * 256;
                    att::stick_sample_split(rowb + h * 256, AO + (size_t)(NP + sb * DSEQ) * AOW + h * 256, (const char*)ck, (const char*)cv, (size_t)TOKW * 4, PAST,
                                            (const char*)(rowb + TOKW + h * 256), (const char*)(rowb + 2 * TOKW + h * 256), (size_t)QKVW * 2, DSEQ, (LAS char*)lds, wave, lane);
                });
#else
                WAIT_CTR(0); WAIT_CTR(1); WAIT_CTR(2);
                { LAS char* vt = (LAS char*)lds + wave * VT_STRIDE;
                for (int it = gw; it < DBAT * 4; it += NGW) {
                    const int h = it % 4, sb = it / 4;
                    const bf16* rowb = QKV + (size_t)(NP + sb * DSEQ) * QKVW;
                    const float* ck = P.in[5] + ((size_t)(j * DBAT + sb) * PAST) * TOKW + h * 256; const float* cv = P.in[6] + ((size_t)(j * DBAT + sb) * PAST) * TOKW + h * 256;
                    att::stick_item<true>(rowb + h * 256, 0, AO + (size_t)(NP + sb * DSEQ) * AOW + h * 256,
                                          (const char*)ck, (const char*)cv, (size_t)TOKW * 4, PAST,
                                          (const char*)(rowb + TOKW + h * 256), (const char*)(rowb + 2 * TOKW + h * 256), (size_t)QKVW * 2, DSEQ, vt, lane);
                }
                __syncthreads(); }
#endif
            }
            DYN_ITEMS(qctr + 192, NB * 4 * (SEQ / 256), {
                const int qb = it % (SEQ / 256), h = (it / (SEQ / 256)) % 4, b = it / (4 * (SEQ / 256));
                WAIT_CTR(b); WAIT_CTR(3);
                const bf16* kb = MKV + (size_t)l * NMR * 1024 + (size_t)b * NMEM * 1024 + h * 128;
                att::softmax_block<false>(QKV + (size_t)(b * SEQ + qb * 256) * QKVW + 3 * TOKW + h * 128, AO + (size_t)(b * SEQ + qb * 256) * AOW + TOKW + h * 128,
                                          (const char*)kb, (const char*)(kb + MEMW), (size_t)1024 * 2, 0, NMEM / 64, 0, nullptr, (LAS char*)lds, tid);
            });
            DYN_ITEMS(qctr + 128, DBAT * 2, {
                WAIT_CTR(2); WAIT_CTR(3);
                const int it2 = it * 2 + (wave >> 2), sp = wave & 3, h = it2 % 4, sb = it2 / 4;
                const float* ck = P.in[7] + ((size_t)(l * DBAT + sb) * NMEM) * MEMW + h * 128; const float* cv = P.in[8] + ((size_t)(l * DBAT + sb) * NMEM) * MEMW + h * 128;
                att::softmax_item<1, true, 4>(QKV + (size_t)(NP + sb * DSEQ) * QKVW + 3 * TOKW + h * 128, 0, AO + (size_t)(NP + sb * DSEQ) * AOW + TOKW + h * 128,
                                              (const char*)ck, (const char*)cv, (size_t)MEMW * 4, sp * 64, sp * 64 + 64, NMEM, 0,
                                              nullptr, nullptr, 0, 0, 0, 1, 0, nullptr, (LAS char*)lds, wave, lane);
            });
#undef DYN_ITEMS
#undef WAIT_CTR
        }
        SEAM(pb + 3);
        if (IN(pb + 4)) {
            dbase = 0; Gated<XcdDeal> S; int bx = blockIdx.x; asm volatile("" : "+s"(bx)); S.init(8, 16, bx, dbase); S.rdy = -1; S.g = Gate{nullptr, 0u, PCW(3), TMOW, W0};
            run_resid<false>(lds, AO, (const bf16*)(LW + LW_O), AOW, S, XB, nullptr, ssqA, TAB1, tidv);
        }
        if (IN(pb + 5)) {
            int bx = blockIdx.x; asm volatile("" : "+s"(bx));
            Gated<XcdDeal> S; S.init(24, 48, bx, dbase); S.rdy = -1; S.g = Gate{PCW(3), 64u, PCW(4), TMOW, W0};
            run_up(lds, XB, (const bf16*)(LW + LW_2U), S, HB, ssqA, tidv);
        }
        if (IN(pb + 6)) {
            Gated<DynDeal> S; int bx = blockIdx.x; asm volatile("" : "+s"(bx)); S.nN = 8; S.T = 16; S.x = bx & 7; S.w0 = W0; S.ctr = ctl + DC_WORD0 + (l * 2 + 1) * 128; S.par = 0; dbase += 130; S.rdy = -1; S.g = Gate{PCW(4), 192u, l + 1 < NLAYER ? PCW(5) : nullptr, TMOW, W0};
            run_resid<true>(lds, HB, (const bf16*)(LW + LW_2D), DFF, S, XB, l == NLAYER - 1 ? out : nullptr, ssqB, TAB1, tidv);
        }
    }
#undef IN
#undef SEAM
#undef PCW
#undef TMOW
#undef W0
}

extern "C" void kernel_launch(void* const* d_in, const int* in_sizes, int n_in, void* d_out, int out_size, void* d_ws, size_t ws_size, hipStream_t stream) {
    static int grid = 0;
    if (grid == 0) {
        if (n_in != 25 || (size_t)out_size != O_END || ws_size < WS_END) { fprintf(stderr, "kernel_launch: unexpected shapes (n_in %d out %d ws %zu)\n", n_in, out_size, ws_size); grid = -1; return; }
        int dev = 0, cus = 0, per_cu = 0;
        if (hipGetDevice(&dev) != hipSuccess || hipDeviceGetAttribute(&cus, hipDeviceAttributeMultiprocessorCount, dev) != hipSuccess) { grid = -1; return; }
        if (hipFuncSetAttribute((const void*)fwd, hipFuncAttributeMaxDynamicSharedMemorySize, LDS_BYTES) != hipSuccess) { fprintf(stderr, "kernel_launch: hipFuncSetAttribute failed\n"); grid = -1; return; }
        if (hipOccupancyMaxActiveBlocksPerMultiprocessor(&per_cu, (const void*)fwd, 512, LDS_BYTES) != hipSuccess || per_cu < 1) { fprintf(stderr, "kernel_launch: occupancy query says %d\n", per_cu); (void)hipGetLastError(); grid = -1; return; }
        if (cus < 256) { fprintf(stderr, "kernel_launch: %d CUs; this kernel's unit orders are built for 256 resident workgroups\n", cus); grid = -1; return; }
        grid = 256;
    }
    if (grid < 0) return;
    (void)hipMemsetAsync((char*)d_ws + WS_CTL, 0, CTL_ZERO_BYTES, stream);
    Params p; memset(&p, 0, sizeof(p));
    for (int i = 0; i < 25; ++i) p.in[i] = (const float*)d_in[i];
    p.out = (float*)d_out; p.ws = (unsigned char*)d_ws;
#if MK_MULTI
    for (int k = 0; k < NPH; ++k) { p.ph_lo = k; p.ph_hi = k + 1; hipLaunchKernelGGL(fwd, dim3(grid), dim3(512), LDS_BYTES, stream, p); }
#else
    p.ph_lo = 0; p.ph_hi = NPH; hipLaunchKernelGGL(fwd, dim3(grid), dim3(512), LDS_BYTES, stream, p);
#endif
}
```
